# Optimizing an MI355X kernel written in HIP

```python
import jax, jax.numpy as jnp
from jax import lax
import numpy as np

D_MODEL = 2048
BATCH = 8
SEQ = 2048
DEPTH = 1

CHUNK = 64
GMLP_WIDTH = D_MODEL // 2
RWKV_WIDTH = D_MODEL - GMLP_WIDTH
GMLP_BLOCK = 128
GMLP_HEADS = 8
GMLP_HEAD_DIM = GMLP_WIDTH // GMLP_HEADS
RWKV_HEAD_DIM = 64
RWKV_HEADS = RWKV_WIDTH // RWKV_HEAD_DIM
DECAY_LORA = 64
AAA_LORA = 64
GATE_LORA = 160
RWKV_IN = 3 * RWKV_WIDTH + DECAY_LORA + AAA_LORA + GATE_LORA
IN_WIDTH = 2 * GMLP_WIDTH + RWKV_IN
PEER_KEYS = 128
PEER_EXPERTS = PEER_KEYS * PEER_KEYS
PEER_HEADS = 8
PEER_TOPK = 16
PEER_QK_HALF = 128
PEER_TOKEN_BLOCK = 128
N_MOD = 6
NORM_EPS = 1e-6
LN_EPS = 1e-5
GROUPNORM_EPS = 64e-5

kernel_name = "hybrid_gmlp_rwkv7_peer_adaln_block"


def rms_norm(x, g):
    xf = x.astype(jnp.float32)
    y = xf * lax.rsqrt(jnp.mean(xf * xf, axis=-1, keepdims=True) + NORM_EPS)
    return (y * g.astype(jnp.float32)).astype(x.dtype)


def layer_norm(x, g, b, eps):
    xf = x.astype(jnp.float32)
    mu = jnp.mean(xf, axis=-1, keepdims=True)
    var = jnp.mean(jnp.square(xf - mu), axis=-1, keepdims=True)
    y = (xf - mu) * lax.rsqrt(var + eps)
    return (y * g.astype(jnp.float32) + b.astype(jnp.float32)).astype(x.dtype)


def modulate(h, shift, scale):
    return h * (1 + scale[:, None, :]) + shift[:, None, :]


def gmlp_spatial_gate(u, v, v_g, v_b, w_s, b_s):
    bsz, seq, _ = u.shape
    vn = layer_norm(v, v_g, v_b, LN_EPS)
    chunk_id = jnp.arange(GMLP_BLOCK) // CHUNK
    mask = (chunk_id[None, :] <= chunk_id[:, None]).astype(w_s.dtype)
    vb = vn.reshape(bsz, seq // GMLP_BLOCK, GMLP_BLOCK, GMLP_HEADS, GMLP_HEAD_DIM)
    z = jnp.einsum("hij,bnjhd->bnihd", w_s * mask, vb) + b_s.T[None, None, :, :, None]
    return u * z.reshape(bsz, seq, GMLP_WIDTH)


def token_shift(p):
    return jnp.pad(p, ((0, 0), (1, 0), (0, 0)))[:, :-1]


def wkv7_scan(r, decay, k, v, a_vec, b_vec):
    bsz, _, nh, n = r.shape
    xs = tuple(jnp.moveaxis(t, 1, 0) for t in (r, decay, k, v, a_vec, b_vec))

    def step(state, inp):
        r_t, w_t, k_t, v_t, a_t, b_t = inp
        sa = jnp.einsum("bhvk,bhk->bhv", state, a_t)
        state = (state * w_t[:, :, None, :]
                 + sa[..., None] * b_t[:, :, None, :]
                 + v_t[..., None] * k_t[:, :, None, :])
        y_t = jnp.einsum("bhvk,bhk->bhv", state, r_t)
        return state, y_t

    s0 = jnp.zeros((bsz, nh, n, n), jnp.float32)
    _, ys = lax.scan(step, s0, xs)
    return jnp.moveaxis(ys, 0, 1)


def rwkv7_time_mix(p, mu, w0, w2, a0, a2, g2, k_k, k_a, r_k, ln_g, ln_b):
    bsz, seq, _ = p.shape
    f32 = jnp.float32
    p = p + (token_shift(p) - p) * mu
    cuts = [RWKV_WIDTH, 2 * RWKV_WIDTH, 3 * RWKV_WIDTH,
            3 * RWKV_WIDTH + DECAY_LORA, 3 * RWKV_WIDTH + DECAY_LORA + AAA_LORA]
    r, k, v, wl, al, gl = jnp.split(p, cuts, axis=-1)
    w = -jax.nn.softplus(-(w0 + jnp.tanh(wl) @ w2)) - 0.5
    a = jax.nn.sigmoid(a0 + al @ a2)
    g = jax.nn.sigmoid(gl) @ g2

    def heads(t):
        return t.reshape(bsz, seq, RWKV_HEADS, RWKV_HEAD_DIM).astype(f32)

    kk = heads(k * k_k)
    kk = kk / jnp.maximum(jnp.sqrt(jnp.sum(kk * kk, axis=-1, keepdims=True)), 1e-12)
    k = k * (1 + (a - 1) * k_a)
    rh, kh, vh, ah = heads(r), heads(k), heads(v), heads(a)
    decay = jnp.exp(-jnp.exp(heads(w)))
    y = wkv7_scan(rh, decay, kh, vh, -kk, kk * ah)
    y = layer_norm(y, ln_g.reshape(RWKV_HEADS, RWKV_HEAD_DIM),
                   ln_b.reshape(RWKV_HEADS, RWKV_HEAD_DIM), GROUPNORM_EPS)
    bonus = jnp.sum(rh * kh * r_k.astype(f32), axis=-1, keepdims=True) * vh
    return (y + bonus).reshape(bsz, seq, RWKV_WIDTH).astype(p.dtype) * g


def peer_ffn(h, w_q, sub_keys, expert_u, expert_v):
    bsz, seq, d = h.shape
    f32 = jnp.float32
    q = (h @ w_q).reshape(bsz, seq, PEER_HEADS, 2, PEER_QK_HALF).astype(f32)
    scores = jnp.einsum("bshpd,hpnd->bshpn", q, sub_keys.astype(f32))
    s_top, i_top = lax.top_k(scores, PEER_TOPK)
    cand = s_top[..., 0, :, None] + s_top[..., 1, None, :]
    cand_idx = i_top[..., 0, :, None] * PEER_KEYS + i_top[..., 1, None, :]
    cand = cand.reshape(bsz, seq, PEER_HEADS, PEER_TOPK * PEER_TOPK)
    cand_idx = cand_idx.reshape(bsz, seq, PEER_HEADS, PEER_TOPK * PEER_TOPK)
    s_fin, pos = lax.top_k(cand, PEER_TOPK)
    e_idx = jnp.take_along_axis(cand_idx, pos, axis=-1)
    gate = jax.nn.softmax(s_fin, axis=-1).astype(h.dtype)

    n_sel = PEER_HEADS * PEER_TOPK
    n_blocks = (bsz * seq) // PEER_TOKEN_BLOCK
    hb = h.reshape(n_blocks, PEER_TOKEN_BLOCK, d)
    eb = e_idx.reshape(n_blocks, PEER_TOKEN_BLOCK, n_sel)
    gb = gate.reshape(n_blocks, PEER_TOKEN_BLOCK, n_sel)

    def block(args):
        hx, ei, gi = args
        u_sel = expert_u[ei]
        act = jax.nn.gelu(jnp.einsum("tkd,td->tk", u_sel, hx), approximate=False) * gi
        return jnp.einsum("tk,tkd->td", act, expert_v[ei])

    out = lax.map(block, (hb, eb, gb))
    return out.reshape(bsz, seq, d)


def setup_inputs(seed: int = 0) -> dict:
    key = jax.random.key(seed)
    ks = jax.random.split(key, 32)
    f32 = jnp.float32
    L, D = DEPTH, D_MODEL

    def nrm(k, shape, std):
        return jax.random.normal(k, shape, f32) * std

    def gain(k, shape):
        return 1.0 + nrm(k, shape, 0.02)

    return {
        "x": nrm(ks[0], (BATCH, SEQ, D), 1.0),
        "c": nrm(ks[1], (BATCH, D), 1.0),
        "ada_w": nrm(ks[2], (L, D, N_MOD * D), 0.5 * D ** -0.5),
        "ada_b": nrm(ks[3], (L, N_MOD * D), 0.01),
        "norm1_g": gain(ks[4], (L, D)),
        "w_in": nrm(ks[5], (L, D, IN_WIDTH), D ** -0.5),
        "gmlp_v_g": gain(ks[6], (L, GMLP_WIDTH)),
        "gmlp_v_b": nrm(ks[7], (L, GMLP_WIDTH), 0.02),
        "gmlp_ws": nrm(ks[8], (L, GMLP_HEADS, GMLP_BLOCK, GMLP_BLOCK), GMLP_BLOCK ** -0.5),
        "gmlp_bs": gain(ks[9], (L, GMLP_HEADS, GMLP_BLOCK)),
        "gmlp_out_g": gain(ks[10], (L, GMLP_WIDTH)),
        "rwkv_mu": jax.random.uniform(ks[11], (L, RWKV_IN), f32),
        "rwkv_w0": jax.random.uniform(ks[12], (L, RWKV_WIDTH), f32, -6.5, -1.5),
        "rwkv_w2": nrm(ks[13], (L, DECAY_LORA, RWKV_WIDTH), 0.1 * DECAY_LORA ** -0.5),
        "rwkv_a0": nrm(ks[14], (L, RWKV_WIDTH), 0.1),
        "rwkv_a2": nrm(ks[15], (L, AAA_LORA, RWKV_WIDTH), 0.1 * AAA_LORA ** -0.5),
        "rwkv_g2": nrm(ks[16], (L, GATE_LORA, RWKV_WIDTH), GATE_LORA ** -0.5),
        "rwkv_kk": 0.85 + nrm(ks[17], (L, RWKV_WIDTH), 0.02),
        "rwkv_ka": gain(ks[18], (L, RWKV_WIDTH)),
        "rwkv_rk": nrm(ks[19], (L, RWKV_HEADS, RWKV_HEAD_DIM), 0.1),
        "rwkv_ln_g": gain(ks[20], (L, RWKV_WIDTH)),
        "rwkv_ln_b": nrm(ks[21], (L, RWKV_WIDTH), 0.02),
        "w_out": nrm(ks[22], (L, D, D), D ** -0.5),
        "norm2_g": gain(ks[23], (L, D)),
        "peer_wq": nrm(ks[24], (L, D, PEER_HEADS * 2 * PEER_QK_HALF), D ** -0.5),
        "peer_keys": nrm(ks[25], (L, PEER_HEADS, 2, PEER_KEYS, PEER_QK_HALF), PEER_QK_HALF ** -0.5),
        "peer_u": nrm(ks[26], (L, PEER_EXPERTS, D), D ** -0.5),
        "peer_v": nrm(ks[27], (L, PEER_EXPERTS, D), PEER_HEADS ** -0.5),
        "final_g": gain(ks[28], (D,)),
    }


def reference(x, c, ada_w, ada_b, norm1_g, w_in, gmlp_v_g, gmlp_v_b, gmlp_ws, gmlp_bs,
              gmlp_out_g, rwkv_mu, rwkv_w0, rwkv_w2, rwkv_a0, rwkv_a2, rwkv_g2, rwkv_kk,
              rwkv_ka, rwkv_rk, rwkv_ln_g, rwkv_ln_b, w_out, norm2_g, peer_wq, peer_keys,
              peer_u, peer_v, final_g):
    for l in range(DEPTH):
        mod = jax.nn.silu(c) @ ada_w[l] + ada_b[l]
        sh1, sc1, gt1, sh2, sc2, gt2 = jnp.split(mod, N_MOD, axis=-1)

        h = modulate(rms_norm(x, norm1_g[l]), sh1, sc1)
        p = h @ w_in[l]
        u, v, p_rwkv = jnp.split(p, [GMLP_WIDTH, 2 * GMLP_WIDTH], axis=-1)
        y_a = gmlp_spatial_gate(jax.nn.gelu(u, approximate=False), jax.nn.gelu(v, approximate=False),
                                gmlp_v_g[l], gmlp_v_b[l], gmlp_ws[l], gmlp_bs[l])
        y_a = rms_norm(y_a, gmlp_out_g[l])
        y_b = rwkv7_time_mix(p_rwkv, rwkv_mu[l], rwkv_w0[l], rwkv_w2[l], rwkv_a0[l], rwkv_a2[l],
                             rwkv_g2[l], rwkv_kk[l], rwkv_ka[l], rwkv_rk[l], rwkv_ln_g[l], rwkv_ln_b[l])
        y = jnp.concatenate([y_a, y_b], axis=-1) @ w_out[l]
        x = x + gt1[:, None, :] * y

        h = modulate(rms_norm(x, norm2_g[l]), sh2, sc2)
        x = x + gt2[:, None, :] * peer_ffn(h, peer_wq[l], peer_keys[l], peer_u[l], peer_v[l])
    return rms_norm(x, final_g)
```

```cpp
#include <hip/hip_runtime.h>
#include <hip/hip_cooperative_groups.h>
#include <cstdio>
#include <cstdint>
namespace cg = cooperative_groups;

#ifndef MK_ONE_LAUNCH
#define MK_ONE_LAUNCH 1
#endif

namespace pg8 {
#define PG8_LAS __attribute__((address_space(3)))
typedef unsigned short bf16_t;
typedef short bf16x8 __attribute__((ext_vector_type(8)));
typedef float f32x4 __attribute__((ext_vector_type(4)));
typedef float f32x2 __attribute__((ext_vector_type(2)));
typedef unsigned u32x4 __attribute__((ext_vector_type(4)));
constexpr int BM = 256, BK = 64, HALF = 128, HTB = HALF * BK * 2, STAGE_BYTES = 8 * HTB, NXCD = 8, WGM = 8;

__host__ __device__ __forceinline__ int lds_byte(int r, int c) { const int st = (r >> 4) * 2 + (c >> 5), rr = r & 15, cc = c & 31, ob = rr * 64 + cc * 2; return st * 1024 + (ob ^ (((ob >> 9) & 1) << 5)); }
__host__ __device__ __forceinline__ void stage_rc(int b, int& R, int& C) { const int st = b / 1024, sb = b % 1024, swz = sb ^ (((sb >> 9) & 1) << 5); R = (st >> 1) * 16 + swz / 64; C = (st & 1) * 32 + (swz % 64) / 2; }
__host__ __device__ __forceinline__ int perm32(int rho) { const int n = rho >> 4, i = rho & 15; return 8 * (i >> 2) + 4 * n + (i & 3); }

struct Unit { int pm, pn; };
struct Gemm { const bf16_t* A; const bf16_t* Bt; int M, N, K; };

struct StaticOrder {
    int nM, nN, nwg, G, c, rep;
    __host__ __device__ void init(int M, int N, int G_, int c_, int rep_ = 1) { nM = M / BM; nN = N / BM; nwg = nM * nN; G = G_; c = c_; rep = rep_; }
    __host__ __device__ bool next(int i, Unit& u) const {
        const long L = (long)i * G + c; if (L >= (long)nwg * rep) return false;
        int wgid = (int)(L % nwg); { const int q = nwg / NXCD, r = nwg % NXCD, xcd = wgid % NXCD, off = wgid / NXCD; wgid = (xcd < r ? xcd * (q + 1) : r * (q + 1) + (xcd - r) * q) + off; }
        const int nig = WGM * nN, gid = wgid / nig, fm = gid * WGM, gsz = (nM - fm) < WGM ? (nM - fm) : WGM;
        u.pm = fm + ((wgid % nig) % gsz); u.pn = (wgid % nig) / gsz; return true;
    }
    __device__ __forceinline__ void a_ready(const Unit&) const {}
    __device__ __forceinline__ void done(const Unit&) const {}
};

__device__ __forceinline__ unsigned cvt_pk_bf16(float lo, float hi) { unsigned r; asm("v_cvt_pk_bf16_f32 %0, %1, %2" : "=v"(r) : "v"(lo), "v"(hi)); return r; }
__device__ __forceinline__ f32x2 gelu_pk(f32x2 v) {
    const f32x2 av = __builtin_elementwise_abs(v), d = av * 0.2316418882f + 1.0f;
    f32x2 t; t.x = __builtin_amdgcn_rcpf(d.x); t.y = __builtin_amdgcn_rcpf(d.y);
    f32x2 q = t * 0.5307027145f + (-0.7265760135f); q = q * t + 0.7107068705f; q = q * t + (-0.142248368f); q = q * t + 0.127414796f; q = q * t;
    const f32x2 s = (v * v) * (-0.72134752044f);
    f32x2 e; e.x = __builtin_amdgcn_exp2f(s.x); e.y = __builtin_amdgcn_exp2f(s.y);
    const f32x2 m = v * (q * e), r = v - m;
    f32x2 o; o.x = v.x < 0.f ? m.x : r.x; o.y = v.y < 0.f ? m.y : r.y; return o;
}

struct EpiBf16G {
    static constexpr bool PERM = true, AFTER_DRAIN = false;
    bf16_t* O; int ldc; int gelu_tiles;
    __device__ __forceinline__ void operator()(const f32x4 (&acc)[2][2][4][2], const Unit& u, int wr, int wc, int fr, int fq) const {
        const int row0 = u.pm * BM + wr * 64 + fr; const int col0 = u.pn * BM + wc * 32 + 8 * fq;
        const bool g = u.pn < gelu_tiles;
#pragma unroll
        for (int ai = 0; ai < 2; ++ai)
#pragma unroll
            for (int m = 0; m < 4; ++m) { bf16_t* rowp = O + (size_t)(row0 + ai * HALF + m * 16) * ldc + col0;
#pragma unroll
                for (int bj = 0; bj < 2; ++bj) { f32x4 v0 = acc[ai][bj][m][0], v1 = acc[ai][bj][m][1];
                    if (g) { f32x2 a = gelu_pk((f32x2){v0[0], v0[1]}), b = gelu_pk((f32x2){v0[2], v0[3]}), c = gelu_pk((f32x2){v1[0], v1[1]}), d = gelu_pk((f32x2){v1[2], v1[3]});
                        v0 = (f32x4){a.x, a.y, b.x, b.y}; v1 = (f32x4){c.x, c.y, d.x, d.y}; }
                    u32x4 w; w.x = cvt_pk_bf16(v0[0], v0[1]); w.y = cvt_pk_bf16(v0[2], v0[3]); w.z = cvt_pk_bf16(v1[0], v1[1]); w.w = cvt_pk_bf16(v1[2], v1[3]);
                    *(u32x4*)(rowp + bj * HALF) = w; } }
    }
};
struct EpiRes {
    static constexpr bool PERM = false, AFTER_DRAIN = false;
    const float* x; float* out; const float* gate; int gstride;
    __device__ __forceinline__ void operator()(const f32x4 (&acc)[2][2][4][2], const Unit& u, int wr, int wc, int fr, int fq) const {
        const int row0 = u.pm * BM + wr * 64 + fr; const int col0 = u.pn * BM + wc * 32 + 4 * fq;
        const float* gp = gate + (size_t)(u.pm >> 3) * gstride + col0;
#pragma unroll
        for (int bj = 0; bj < 2; ++bj)
#pragma unroll
            for (int n = 0; n < 2; ++n) { const f32x4 g4 = *(const f32x4*)(gp + bj * HALF + n * 16);
#pragma unroll
                for (int ai = 0; ai < 2; ++ai)
#pragma unroll
                    for (int m = 0; m < 4; ++m) { const size_t off = (size_t)(row0 + ai * HALF + m * 16) * 2048 + col0 + bj * HALF + n * 16;
                        const f32x4 xv = *(const f32x4*)(x + off); *(f32x4*)(out + off) = xv + g4 * acc[ai][bj][m][n]; }
                asm volatile("" ::: "memory"); }
    }
};

template <class Epi, class Sched, bool ALIGN_EPI = false, bool SP2 = false>
__device__ __forceinline__ void gemm_phase(PG8_LAS unsigned char* lds, const Gemm g, const Sched& S, const Epi& E) {
    const int tid = threadIdx.x, wid = __builtin_amdgcn_readfirstlane(tid >> 6), lane = tid & 63, wr = wid >> 2, wc = wid & 3, fr = lane & 15, fq = lane >> 4;
    const int K = g.K, nt = K / BK;
    unsigned voffA[2], voffB[2];
#pragma unroll
    for (int i = 0; i < 2; ++i) { int R, C; stage_rc(tid * 16 + i * 8192, R, C); const int Rb = Epi::PERM ? ((R & ~31) + perm32(R & 31)) : R;
        voffA[i] = (unsigned)(R * K + C) * 2u; voffB[i] = (unsigned)(Rb * K + C) * 2u; }
    const size_t kstep = (size_t)(BK * 2);
    const size_t hstep = (size_t)HALF * K * 2;
    const size_t tstep = 2 * hstep;
    const unsigned ldsw = (unsigned)wid * 1024u;
    const int aoff = lds_byte(wr * 64 + fr, fq * 8), boff = lds_byte(wc * 32 + fr, fq * 8);
#define PG8_SA(b, h) (((b) * 2 + (h)) * HTB)
#define PG8_SB(b, h) ((4 + (b) * 2 + (h)) * HTB)
#define PG8_STAGE(bufoff, gbase, voff) do { _Pragma("unroll") for (int _i = 0; _i < 2; ++_i) \
        __builtin_amdgcn_global_load_lds((const unsigned*)((const char*)(gbase) + (voff)[_i]), (PG8_LAS unsigned*)(lds + (bufoff) + ldsw + _i * 8192), 16, 0, 0); } while (0)
#define PG8_LDA(dst, b, h) do { _Pragma("unroll") for (int m = 0; m < 4; ++m) _Pragma("unroll") for (int k = 0; k < 2; ++k) dst[m][k] = *(const PG8_LAS bf16x8*)(lds + PG8_SA(b, h) + aoff + m * 2048 + k * 1024); } while (0)
#define PG8_LDB(dst, b, h) do { _Pragma("unroll") for (int n = 0; n < 2; ++n) _Pragma("unroll") for (int k = 0; k < 2; ++k) dst[n][k] = *(const PG8_LAS bf16x8*)(lds + PG8_SB(b, h) + boff + n * 2048 + k * 1024); } while (0)
#define PG8_MMA(ai, bj, At, Bt) do { __builtin_amdgcn_s_setprio(1); _Pragma("unroll") for (int m = 0; m < 4; ++m) _Pragma("unroll") for (int n = 0; n < 2; ++n) _Pragma("unroll") for (int k = 0; k < 2; ++k) \
        acc[ai][bj][m][n] = __builtin_amdgcn_mfma_f32_16x16x32_bf16(Bt[n][k], At[m][k], acc[ai][bj][m][n], 0, 0, 0); __builtin_amdgcn_s_setprio(0); } while (0)
#define PG8_WAIT_V(n) asm volatile("s_waitcnt vmcnt(" #n ")" ::: "memory")
#define PG8_WAIT_L(n) asm volatile("s_waitcnt lgkmcnt(" #n ")" ::: "memory")
#define PG8_BAR __builtin_amdgcn_s_barrier()
#define PG8_SCHED __builtin_amdgcn_sched_barrier(0)
    Unit cur, nxt; int ui = 0;
    if (!S.next(0, cur)) return;
    f32x4 acc[2][2][4][2];
#pragma unroll
    for (int a = 0; a < 2; ++a)
#pragma unroll
        for (int b = 0; b < 2; ++b)
#pragma unroll
            for (int m = 0; m < 4; ++m)
#pragma unroll
                for (int n = 0; n < 2; ++n) acc[a][b][m][n] = (f32x4){0.f, 0.f, 0.f, 0.f};
    bf16x8 At[4][2], B0[2][2], B1[2][2];
    const char* cA = (const char*)g.A + (size_t)cur.pm * tstep; const char* cB = (const char*)g.Bt + (size_t)cur.pn * tstep;
    S.a_ready(cur);
    if constexpr (SP2) {
        PG8_STAGE(PG8_SB(0, 0), cB, voffB); PG8_STAGE(PG8_SB(0, 1), cB + hstep, voffB); PG8_STAGE(PG8_SA(0, 0), cA, voffA); PG8_STAGE(PG8_SA(0, 1), cA + hstep, voffA);
        if (wr == 1) PG8_BAR;
        PG8_WAIT_V(2); PG8_BAR;
        PG8_STAGE(PG8_SB(1, 0), cB + kstep, voffB); PG8_STAGE(PG8_SA(1, 0), cA + kstep, voffA); PG8_STAGE(PG8_SB(1, 1), cB + hstep + kstep, voffB);
        PG8_WAIT_V(6); PG8_BAR;
    } else {
        PG8_STAGE(PG8_SB(0, 0), cB, voffB); PG8_STAGE(PG8_SA(0, 0), cA, voffA); PG8_STAGE(PG8_SB(0, 1), cB + hstep, voffB); PG8_STAGE(PG8_SA(0, 1), cA + hstep, voffA);
        if (wr == 1) PG8_BAR;
        PG8_WAIT_V(4); PG8_BAR;
        PG8_STAGE(PG8_SB(1, 0), cB + kstep, voffB); PG8_STAGE(PG8_SA(1, 0), cA + kstep, voffA); PG8_STAGE(PG8_SB(1, 1), cB + hstep + kstep, voffB);
        PG8_WAIT_V(6); PG8_BAR;
    }
    for (;;) {
        const bool has_next = S.next(ui + 1, nxt);
        const char* nA = has_next ? (const char*)g.A + (size_t)nxt.pm * tstep : cA; const char* nB = has_next ? (const char*)g.Bt + (size_t)nxt.pn * tstep : cB;
        for (int t = 0; t < nt; t += 2) {
            const bool last = (t == nt - 2);
            const char* a1 = cA + (size_t)(t + 1) * kstep;
            const char* a2 = last ? nA : cA + (size_t)(t + 2) * kstep; const char* b2 = last ? nB : cB + (size_t)(t + 2) * kstep;
            const char* a3 = a2 + kstep; const char* b3 = b2 + kstep;
            if (last && has_next) S.a_ready(nxt);
            if constexpr (SP2) {
            PG8_LDB(B0, 0, 0); PG8_LDB(B1, 0, 1); PG8_SCHED; PG8_LDA(At, 0, 0); PG8_STAGE(PG8_SA(1, 1), a1 + hstep, voffA);
            PG8_WAIT_V(8); PG8_WAIT_L(0); PG8_BAR; PG8_MMA(0, 0, At, B0); PG8_MMA(0, 1, At, B1); PG8_BAR; PG8_SCHED;
            PG8_LDA(At, 0, 1); PG8_STAGE(PG8_SB(0, 0), b2, voffB); PG8_STAGE(PG8_SB(0, 1), b2 + hstep, voffB); PG8_STAGE(PG8_SA(0, 0), a2, voffA);
            PG8_WAIT_V(8); PG8_WAIT_L(0); PG8_BAR; PG8_MMA(1, 0, At, B0); PG8_MMA(1, 1, At, B1); PG8_BAR; PG8_SCHED;
            PG8_LDB(B0, 1, 0); PG8_LDB(B1, 1, 1); PG8_SCHED; PG8_LDA(At, 1, 0); PG8_STAGE(PG8_SA(0, 1), a2 + hstep, voffA);
            PG8_WAIT_V(8); PG8_WAIT_L(0); PG8_BAR; PG8_MMA(0, 0, At, B0); PG8_MMA(0, 1, At, B1); PG8_BAR; PG8_SCHED;
            PG8_LDA(At, 1, 1); PG8_STAGE(PG8_SB(1, 0), b3, voffB); PG8_STAGE(PG8_SB(1, 1), b3 + hstep, voffB); PG8_STAGE(PG8_SA(1, 0), a3, voffA);
            PG8_WAIT_V(8); PG8_WAIT_L(0); PG8_BAR; PG8_MMA(1, 0, At, B0); PG8_MMA(1, 1, At, B1); PG8_BAR; PG8_SCHED;
            } else {
            PG8_LDB(B0, 0, 0); PG8_SCHED; PG8_LDA(At, 0, 0); PG8_STAGE(PG8_SA(1, 1), a1 + hstep, voffA);
            PG8_WAIT_L(8); PG8_BAR; PG8_WAIT_L(0); PG8_MMA(0, 0, At, B0); PG8_BAR; PG8_SCHED;
            PG8_LDB(B1, 0, 1); PG8_STAGE(PG8_SB(0, 0), b2, voffB);
            PG8_BAR; PG8_WAIT_L(0); PG8_MMA(0, 1, At, B1); PG8_BAR;
            PG8_LDA(At, 0, 1); PG8_STAGE(PG8_SA(0, 0), a2, voffA);
            PG8_BAR; PG8_WAIT_L(0); PG8_MMA(1, 0, At, B0); PG8_BAR; PG8_SCHED;
            PG8_STAGE(PG8_SB(0, 1), b2 + hstep, voffB);
            PG8_WAIT_V(6); PG8_BAR; PG8_MMA(1, 1, At, B1); PG8_BAR;
            PG8_LDB(B0, 1, 0); PG8_SCHED; PG8_LDA(At, 1, 0); PG8_STAGE(PG8_SA(0, 1), a2 + hstep, voffA);
            PG8_WAIT_L(8); PG8_BAR; PG8_WAIT_L(0); PG8_MMA(0, 0, At, B0); PG8_BAR; PG8_SCHED;
            PG8_LDB(B1, 1, 1); PG8_STAGE(PG8_SB(1, 0), b3, voffB);
            PG8_BAR; PG8_WAIT_L(0); PG8_MMA(0, 1, At, B1); PG8_BAR;
            PG8_LDA(At, 1, 1); PG8_STAGE(PG8_SA(1, 0), a3, voffA);
            PG8_BAR; PG8_WAIT_L(0); PG8_MMA(1, 0, At, B0); PG8_BAR; PG8_SCHED;
            PG8_STAGE(PG8_SB(1, 1), b3 + hstep, voffB);
            PG8_WAIT_V(6); PG8_BAR; PG8_MMA(1, 1, At, B1); PG8_BAR;
            }
        }
        if constexpr (ALIGN_EPI) { if (wr == 0) PG8_BAR; }
        if constexpr (!Epi::AFTER_DRAIN) { E(acc, cur, wr, wc, fr, fq); S.done(cur); }
        if (!has_next) break;
#pragma unroll
        for (int a = 0; a < 2; ++a)
#pragma unroll
            for (int b = 0; b < 2; ++b)
#pragma unroll
                for (int m = 0; m < 4; ++m)
#pragma unroll
                    for (int n = 0; n < 2; ++n) acc[a][b][m][n] = (f32x4){0.f, 0.f, 0.f, 0.f};
        cur = nxt; cA = nA; cB = nB; ++ui;
        if constexpr (ALIGN_EPI) { if (wr == 1) PG8_BAR; }
    }
    PG8_WAIT_V(0);
    if constexpr (!ALIGN_EPI) { if (wr == 0) PG8_BAR; }
    PG8_BAR;
#undef PG8_SA
#undef PG8_SB
#undef PG8_STAGE
#undef PG8_LDA
#undef PG8_LDB
#undef PG8_MMA
#undef PG8_WAIT_V
#undef PG8_WAIT_L
#undef PG8_BAR
#undef PG8_SCHED
}
}

typedef unsigned short bf16;
typedef float f32x4 __attribute__((ext_vector_type(4)));
typedef float f32x2 __attribute__((ext_vector_type(2)));
typedef float f32x16 __attribute__((ext_vector_type(16)));
typedef short bf16x8 __attribute__((ext_vector_type(8)));
typedef unsigned u32x4 __attribute__((ext_vector_type(4)));
typedef unsigned u32x2 __attribute__((ext_vector_type(2)));
typedef __bf16 bf16v2 __attribute__((ext_vector_type(2)));

constexpr int NW = 8, NT = 512;
constexpr int MTOK = 16384, SEQ = 2048, DM = 2048, NIN = 5408, NINP = 5632, NMODC = 12288;
constexpr size_t MiB = 1u << 20;
constexpr size_t WS_MOD = 1 * MiB, WS_KEYS = 2 * MiB, WS_W2T = WS_KEYS + 512 * 1024, WS_A2T = WS_W2T + 128 * 1024, WS_G2T = WS_A2T + 128 * 1024;
constexpr size_t WS_WIN = 4 * MiB, WS_WOUT = 26 * MiB, WS_WQ = 34 * MiB, WS_PU = 42 * MiB, WS_PV = 106 * MiB, WS_HB = 170 * MiB, WS_P = 234 * MiB;
constexpr size_t WS_KP = 410 * MiB, WS_KK = 442 * MiB, WS_BB = 474 * MiB, WS_VV = 506 * MiB, WS_END = 538 * MiB;
constexpr size_t WS_Y = WS_P, WS_Q = WS_P + 64 * MiB, WS_EIDX = WS_P + 128 * MiB, WS_GATE = WS_P + 136 * MiB;
constexpr size_t OUT_DEC = 0, OUT_G = 64 * MiB, OUT_R = 96 * MiB;
constexpr int LDS_BYTES = 147456;
constexpr int XB_LDS_OFF = 147456 - 64;
constexpr size_t CTL_ZERO_BYTES = 16384;
constexpr int NPHASE = 11;

struct Args { const float* in[29]; float* out; unsigned char* ws; int ph_lo, ph_hi; };

__device__ __forceinline__ float bf_lo(unsigned u) { return __uint_as_float(u << 16); }
__device__ __forceinline__ float bf_hi(unsigned u) { return __uint_as_float(u & 0xffff0000u); }
__device__ __forceinline__ float bf1(bf16 h) { return __uint_as_float((unsigned)h << 16); }
__device__ __forceinline__ unsigned pk2(float lo, float hi) { return pg8::cvt_pk_bf16(lo, hi); }
__device__ __forceinline__ bf16 f2bf(float f) { return (bf16)(pg8::cvt_pk_bf16(f, 0.f) & 0xffffu); }
template <int CTRL> __device__ __forceinline__ float dpp_mov(float v) { return __int_as_float(__builtin_amdgcn_update_dpp(0, __float_as_int(v), CTRL, 0xF, 0xF, true)); }
__device__ __forceinline__ float quad_sum(float v) { v += dpp_mov<0xB1>(v); v += dpp_mov<0x4E>(v); return v; }
__device__ __forceinline__ float row16_sum(float v) { v = quad_sum(v); v += dpp_mov<0x141>(v); v += dpp_mov<0x140>(v); return v; }
__device__ __forceinline__ float half32_sum(float v) { v = row16_sum(v); v += __shfl_xor(v, 16); return v; }
__device__ __forceinline__ float wave_sum(float v) { v = row16_sum(v); v += __shfl_xor(v, 16); v += __shfl_xor(v, 32); return v; }
__device__ __forceinline__ int kmax(int a, int b) { int r; asm("v_max_f32 %0, %1, %2" : "=v"(r) : "v"(a), "v"(b)); return r; }
__device__ __forceinline__ int kmin(int a, int b) { int r; asm("v_min_f32 %0, %1, %2" : "=v"(r) : "v"(a), "v"(b)); return r; }
__device__ __forceinline__ int kmed3(int a, int b, int c) { int r; asm("v_med3_f32 %0, %1, %2, %3" : "=v"(r) : "v"(a), "v"(b), "v"(c)); return r; }
__device__ __forceinline__ float gelu1(float x) { return 0.5f * x * (1.0f + erff(x * 0.70710678118654752f)); }
__device__ __forceinline__ float sigmoid1(float x) { return __builtin_amdgcn_rcpf(1.0f + __expf(-x)); }
__device__ __forceinline__ float tanh_fast(float x) { const float e = __expf(-2.0f * fabsf(x)); const float t = (1.0f - e) * __builtin_amdgcn_rcpf(1.0f + e); return x < 0.f ? -t : t; }

__device__ __forceinline__ void p0_transpose_item(const float* W, int K, int N, bf16* WT, float* scr, int item, int lane) {
    const int nblk = N / 32, kb = item / nblk, nb = item % nblk, k0 = 64 * kb, n0 = 32 * nb;
#pragma unroll 8
    for (int i = 0; i < 32; ++i) { const int kk = 2 * i + (lane >> 5); scr[kk * 33 + (lane & 31)] = W[(size_t)(k0 + kk) * N + n0 + (lane & 31)]; }
    asm volatile("s_waitcnt lgkmcnt(0)" ::: "memory");
    const int c = lane & 7;
#pragma unroll
    for (int j = 0; j < 4; ++j) { const int n = (lane >> 3) + 8 * j; const float* s = scr + (8 * c) * 33 + n;
        u32x4 o; o.x = pk2(s[0 * 33], s[1 * 33]); o.y = pk2(s[2 * 33], s[3 * 33]); o.z = pk2(s[4 * 33], s[5 * 33]); o.w = pk2(s[6 * 33], s[7 * 33]);
        *(u32x4*)(WT + (size_t)(n0 + n) * K + k0 + 8 * c) = o; }
    asm volatile("s_waitcnt lgkmcnt(0)" ::: "memory");
}

__device__ __forceinline__ void norm_mod_rows(const float* X, const float* g, const float* mod, int shi, int sci, bf16* H, int gw, int NGW, int lane, int rep = 1) {
    for (int t_ = gw; t_ < MTOK * rep; t_ += NGW) { const int t = t_ & (MTOK - 1);
        const int b = t >> 11;
        const f32x4* xr = (const f32x4*)(X + (size_t)t * DM) + lane;
        f32x4 v[8]; float ss = 0.f;
#pragma unroll
        for (int j = 0; j < 8; ++j) { v[j] = xr[64 * j]; ss += (v[j].x * v[j].x + v[j].y * v[j].y) + (v[j].z * v[j].z + v[j].w * v[j].w); }
        ss = wave_sum(ss);
        const float rinv = rsqrtf(ss * (1.0f / DM) + 1e-6f);
        const float* mb = mod + (size_t)b * NMODC;
#pragma unroll
        for (int j = 0; j < 8; ++j) { const int col = 4 * lane + 256 * j;
            const f32x4 g4 = *(const f32x4*)(g + col), sc4 = *(const f32x4*)(mb + sci * DM + col), sh4 = *(const f32x4*)(mb + shi * DM + col);
            const f32x4 o = (v[j] * rinv) * g4 * (sc4 + 1.0f) + sh4;
            u32x2 w; w.x = pk2(o.x, o.y); w.y = pk2(o.z, o.w);
            *(u32x2*)(H + (size_t)t * DM + col) = w; }
    }
}


#define LAS __attribute__((address_space(3)))
#define XB_TMO      128
#define XB_XCNT(j)  (256  + 64 * (j))
#define XB_XSUB(j)  (1280 + 64 * (j))
#define XB_XGEN(j)  (2304 + 64 * (j))
#define XB_TOP      3328
#define XB_TOPGEN   3392
#define XCD_BAR_WORDS 3456
#define XB_SPIN_CAP (1u << 18)

__device__ __forceinline__ unsigned xb_ld(unsigned* p)              { return __hip_atomic_load(p, __ATOMIC_RELAXED, __HIP_MEMORY_SCOPE_AGENT); }
__device__ __forceinline__ unsigned xb_add(unsigned* p, unsigned v) { return __hip_atomic_fetch_add(p, v, __ATOMIC_RELAXED, __HIP_MEMORY_SCOPE_AGENT); }
__device__ __forceinline__ unsigned xb_xcc_id() { return (unsigned)__builtin_amdgcn_s_getreg((3 << 11) | 20) & 0xFu; }
#define XB_SPIN(cond, bar) do { unsigned _sp = 0; while (cond) { __builtin_amdgcn_s_sleep(1); \
    if ((++_sp & 255u) == 0u) { if (xb_ld(&(bar)[XB_TMO])) break; if (_sp > XB_SPIN_CAP) { atomicAdd(&(bar)[XB_TMO], 1u); break; } } } } while (0)

struct XcdBarrier {
    unsigned* bar; unsigned x;
    volatile LAS unsigned* st;
};

__device__ __forceinline__ XcdBarrier xcd_barrier_post(unsigned* bar, volatile LAS unsigned* st) {
    XcdBarrier b; b.bar = bar; b.x = xb_xcc_id(); b.st = st;
    if (threadIdx.x == 0) (void)xb_add(&bar[XB_XCNT(b.x)], 1u);
    return b;
}
__device__ __forceinline__ void xcd_barrier_complete(unsigned* bar, unsigned x, unsigned& nloc, unsigned& nx) {
    const unsigned G = gridDim.x * gridDim.y * gridDim.z;
    unsigned sum, cnt, mine, sp = 0u;
    for (;;) {
        sum = 0u; cnt = 0u; mine = 0u;
#pragma unroll
        for (unsigned j = 0; j < 16; ++j) { const unsigned c = xb_ld(&bar[XB_XCNT(j)]); sum += c; cnt += (c > 0u) ? 1u : 0u; mine = (j == x) ? c : mine; }
        if (sum == G) break;
        __builtin_amdgcn_s_sleep(1);
        if ((++sp & 255u) == 0u) { if (xb_ld(&bar[XB_TMO])) break; if (sp > XB_SPIN_CAP) { atomicAdd(&bar[XB_TMO], 1u); break; } }
    }
    nloc = mine > 0u ? mine : 1u; nx = cnt > 0u ? cnt : 1u;
}

__device__ __forceinline__ void xcd_barrier(const XcdBarrier& b) {
    asm volatile("s_waitcnt vmcnt(0)" ::: "memory");
    __syncthreads();
    if (threadIdx.x == 0) {
        unsigned* bar = b.bar;
        __builtin_amdgcn_s_waitcnt(0);
        unsigned nloc = b.st[0], nx = b.st[1];
        if (nloc == 0u) { xcd_barrier_complete(bar, b.x, nloc, nx); b.st[0] = nloc; b.st[1] = nx; }
        const unsigned old = xb_add(&bar[XB_XSUB(b.x)], 1u);
        const unsigned gen = old / nloc;
        if (old + 1u == (gen + 1u) * nloc) {
            __builtin_amdgcn_fence(__ATOMIC_RELEASE, "agent");
            asm volatile("s_waitcnt vmcnt(0)" ::: "memory");
            const unsigned og = xb_add(&bar[XB_TOP], 1u);
            const unsigned tg = og / nx;
            if (og + 1u == (tg + 1u) * nx) xb_add(&bar[XB_TOPGEN], 1u);
            else XB_SPIN(xb_ld(&bar[XB_TOPGEN]) == tg, bar);
            __builtin_amdgcn_fence(__ATOMIC_ACQUIRE, "agent");
            xb_add(&bar[XB_XGEN(b.x)], 1u);
            asm volatile("s_waitcnt vmcnt(0)" ::: "memory");
        } else {
            XB_SPIN(xb_ld(&bar[XB_XGEN(b.x)]) == gen, bar);
            __builtin_amdgcn_fence(__ATOMIC_ACQUIRE, "agent");
            asm volatile("s_waitcnt vmcnt(0)" ::: "memory");
        }
    }
    __syncthreads();
}


#define CONVERT_EXPERT_ROWS(R0, R1, WID, NWV) do { \
    for (int r = (R0) + (WID); r < (R1); r += (NWV)) { \
        const int row = r & 16383; \
        const float* srcp = args.in[26] + (size_t)row * DM; \
        f32x4 v[8]; float am = 0.f; \
        _Pragma("unroll") for (int j = 0; j < 2; ++j) _Pragma("unroll") for (int q = 0; q < 4; ++q) { const f32x4 t = *(const f32x4*)(srcp + j * 1024 + lane * 16 + q * 4); v[j * 4 + q] = t; \
            am = fmaxf(am, fmaxf(fmaxf(fabsf(t.x), fabsf(t.y)), fmaxf(fabsf(t.z), fabsf(t.w)))); } \
        _Pragma("unroll") for (int o = 1; o < 64; o <<= 1) am = fmaxf(am, __shfl_xor(am, o)); \
        const float sc = am > 0.f ? 240.0f / am : 1.0f, inv = am > 0.f ? am * (1.0f / 240.0f) : 1.0f; \
        unsigned char* dst = PU8 + (size_t)row * DM; \
        _Pragma("unroll") for (int j = 0; j < 2; ++j) { u32x4 o; \
            _Pragma("unroll") for (int q = 0; q < 4; ++q) { const f32x4 t = v[j * 4 + q] * sc; int p = __builtin_amdgcn_cvt_pk_fp8_f32(t.x, t.y, 0, false); p = __builtin_amdgcn_cvt_pk_fp8_f32(t.z, t.w, p, true); o[q] = (unsigned)p; } \
            *(u32x4*)(dst + j * 1024 + lane * 16) = o; } \
        if (lane == 0) SCL[r] = inv; \
    } } while (0)
#define CONVERT_EXPERT_FP4_ROWS(SRC, DST, SCLP, WID, NWV) do { \
    for (int row = (WID); row < 16384; row += (NWV)) { \
        const float* srcp = (SRC) + (size_t)row * DM + lane * 32; \
        f32x4 v[8]; float am = 0.f, ss = 0.f; \
        _Pragma("unroll") for (int q = 0; q < 8; ++q) { const f32x4 t = *(const f32x4*)(srcp + q * 4); v[q] = t; \
            am = fmaxf(am, fmaxf(fmaxf(fabsf(t.x), fabsf(t.y)), fmaxf(fabsf(t.z), fabsf(t.w)))); ss += (t.x * t.x + t.y * t.y) + (t.z * t.z + t.w * t.w); } \
        _Pragma("unroll") for (int o = 1; o < 64; o <<= 1) am = fmaxf(am, __shfl_xor(am, o)); \
        ss = wave_sum(ss); \
        float unit = fmaxf(sqrtf(ss * (1.0f / DM)) * 0.5f, am * (1.0f / 9.0f)); if (!(unit > 0.f)) unit = 1.0f; \
        const float sc = 1.0f / unit; u32x4 o; \
        _Pragma("unroll") for (int d = 0; d < 4; ++d) { const f32x4 t0 = v[2 * d] * sc, t1 = v[2 * d + 1] * sc; unsigned p = 0u; \
            p = __builtin_amdgcn_cvt_scalef32_pk_fp4_f32(p, t0.x, t0.y, 1.0f, 0); p = __builtin_amdgcn_cvt_scalef32_pk_fp4_f32(p, t0.z, t0.w, 1.0f, 1); \
            p = __builtin_amdgcn_cvt_scalef32_pk_fp4_f32(p, t1.x, t1.y, 1.0f, 2); p = __builtin_amdgcn_cvt_scalef32_pk_fp4_f32(p, t1.z, t1.w, 1.0f, 3); o[d] = p; } \
        *(u32x4*)((DST) + (size_t)row * 1024 + lane * 16) = o; \
        if (lane == 0) (SCLP)[row] = unit; \
    } } while (0)

__global__ void __launch_bounds__(NT, 2) mk_fwd(Args args) {
    extern __shared__ __attribute__((aligned(16))) unsigned char lds[];
    const int tid = threadIdx.x, lane = tid & 63, wave = __builtin_amdgcn_readfirstlane(tid >> 6);
    const int G = gridDim.x, bx = blockIdx.x;
    const int gw = bx * NW + wave, NGW = G * NW;
    const int gtid = bx * NT + tid, NGT = G * NT;
    unsigned char* ws = args.ws;
    const int lo = args.ph_lo, hi = args.ph_hi;
    volatile LAS unsigned* xst = (volatile LAS unsigned*)((LAS unsigned char*)lds + XB_LDS_OFF);
    if (tid < 4) xst[tid] = 0u;
    __syncthreads();
    XcdBarrier xbar = xcd_barrier_post((unsigned*)ws, xst);
    if (args.ph_lo == -7777) cg::this_grid().sync();
#ifndef P3SEL
#define P3SEL(x) (x)
#endif
#ifndef PH_MASK
#define PH_MASK 0x7ff
#endif
#define IN(k) (((PH_MASK >> (k)) & 1) && lo <= (k) && (k) < hi)
#ifndef PROBE_REP
#define PROBE_REP -1
#endif
#define REPS(k)
#define RMUL(k) ((k) == PROBE_REP ? 2 : 1)
#define SEAM(k) do { if (IN(k) && IN((k) + 1)) xcd_barrier(xbar); } while (0)

    const float* x = args.in[0];
    float* MOD = (float*)(ws + WS_MOD);
    bf16* KEYSB = (bf16*)(ws + WS_KEYS); bf16* W2T = (bf16*)(ws + WS_W2T); bf16* A2T = (bf16*)(ws + WS_A2T); bf16* G2T = (bf16*)(ws + WS_G2T);
    bf16* WIN = (bf16*)(ws + WS_WIN); bf16* WOUT = (bf16*)(ws + WS_WOUT); bf16* WQ = (bf16*)(ws + WS_WQ);
    unsigned char* PU8 = ws + WS_PU; unsigned char* PV8 = ws + WS_PU + 32 * MiB; float* SCL = (float*)(ws + WS_PV); bf16* HB = (bf16*)(ws + WS_HB); bf16* P = (bf16*)(ws + WS_P);
    bf16* KP = (bf16*)(ws + WS_KP); bf16* KKn = (bf16*)(ws + WS_KK); bf16* BB = (bf16*)(ws + WS_BB); bf16* VV = (bf16*)(ws + WS_VV);
    float* Y = (float*)(ws + WS_Y); bf16* Q = (bf16*)(ws + WS_Q); int* EIDX = (int*)(ws + WS_EIDX); float* GATE = (float*)(ws + WS_GATE);
    float* DEC = (float*)((unsigned char*)args.out + OUT_DEC); bf16* GG = (bf16*)((unsigned char*)args.out + OUT_G); bf16* RR = (bf16*)((unsigned char*)args.out + OUT_R);

    if (IN(0)) REPS(0) {
        if (bx < 192) {
            const float* c = args.in[1]; const float* ada_w = args.in[2]; const float* ada_b = args.in[3];
            float* sct = (float*)lds;
            for (int i = tid; i < 8 * 2048; i += NT) { const int b = i >> 11, k = i & 2047; const float cv = c[i]; sct[k * 8 + b] = cv / (1.0f + __expf(-cv)); }
            __syncthreads();
            const int n0 = bx * 64, rg = lane >> 4, cl = lane & 15;
            f32x4 acc[8];
#pragma unroll
            for (int b = 0; b < 8; ++b) acc[b] = (f32x4){0.f, 0.f, 0.f, 0.f};
            const float* wp = ada_w + (size_t)(wave * 256 + rg) * NMODC + n0 + cl * 4;
#pragma unroll 4
            for (int i = 0; i < 64; ++i) {
                const f32x4 w = *(const f32x4*)(wp + (size_t)i * 4 * NMODC);
                const int k = wave * 256 + i * 4 + rg;
                const f32x4 s0 = *(const f32x4*)(sct + k * 8), s1 = *(const f32x4*)(sct + k * 8 + 4);
                acc[0] += w * s0.x; acc[1] += w * s0.y; acc[2] += w * s0.z; acc[3] += w * s0.w;
                acc[4] += w * s1.x; acc[5] += w * s1.y; acc[6] += w * s1.z; acc[7] += w * s1.w;
            }
            float* red = (float*)(lds + 65536);
#pragma unroll
            for (int b = 0; b < 8; ++b) {
#pragma unroll
                for (int q = 0; q < 4; ++q) { float v = acc[b][q]; v += __shfl_xor(v, 16); v += __shfl_xor(v, 32); acc[b][q] = v; }
                if (rg == 0) *(f32x4*)(red + (wave * 8 + b) * 64 + cl * 4) = acc[b];
            }
            __syncthreads();
            { const int b = tid >> 6, col = tid & 63; float s = ada_b[n0 + col];
#pragma unroll
              for (int w = 0; w < 8; ++w) s += red[(w * 8 + b) * 64 + col];
              MOD[(size_t)b * NMODC + n0 + col] = s; }
            __syncthreads();
        }
        {
            float* scr = (float*)(lds + wave * 16384);
            constexpr int I_IN = (DM / 64) * (NIN / 32), I_SQ = (DM / 64) * (DM / 32);
            for (int it = gw; it < I_IN + 2 * I_SQ; it += NGW) {
                int r = it;
                if (r < I_IN) { p0_transpose_item(args.in[5], DM, NIN, WIN, scr, r, lane); continue; } r -= I_IN;
                if (r < I_SQ) { p0_transpose_item(args.in[22], DM, DM, WOUT, scr, r, lane); continue; } r -= I_SQ;
                p0_transpose_item(args.in[24], DM, DM, WQ, scr, r, lane);
            }
        }
        {
            u32x4* z = (u32x4*)(WIN + (size_t)NIN * DM);
            for (int i = gtid; i < (NINP - NIN) * DM / 8; i += NGT) z[i] = (u32x4){0u, 0u, 0u, 0u};
            const float* w2 = args.in[13]; const float* a2 = args.in[15]; const float* g2 = args.in[16]; const float* keys = args.in[25];
            for (int i = gtid; i < 1024 * 64; i += NGT) { const int n = i >> 6, k = i & 63; W2T[i] = f2bf(w2[k * 1024 + n]); A2T[i] = f2bf(a2[k * 1024 + n]); }
            for (int i = gtid; i < 1024 * 160; i += NGT) { const int n = i / 160, k = i % 160; G2T[i] = f2bf(g2[k * 1024 + n]); }
            for (int i = gtid; i < 262144 / 2; i += NGT) { const f32x2 v = *(const f32x2*)(keys + 2 * i); ((unsigned*)KEYSB)[i] = pk2(v.x, v.y); }
        }
    }
    SEAM(0);

    if (IN(1)) norm_mod_rows(x, args.in[4], MOD, 0, 1, HB, gw, NGW, lane, RMUL(1));
    SEAM(1);

    if (IN(2)) {
        pg8::Gemm g{HB, WIN, MTOK, NINP, DM}; pg8::StaticOrder S; S.init(MTOK, NINP, G, bx, RMUL(2));
        pg8::EpiBf16G E{P, NINP, 8};
        pg8::gemm_phase<pg8::EpiBf16G, pg8::StaticOrder, true, true>((PG8_LAS unsigned char*)lds, g, S, E);
        if (G == 256) { if (bx >= 128) CONVERT_EXPERT_FP4_ROWS(args.in[26], PU8, SCL, (bx - 128) * NW + wave, 128 * NW); }
        else CONVERT_EXPERT_FP4_ROWS(args.in[26], PU8, SCL, gw, NGW);
    }
    SEAM(2);

    if (IN(3)) REPS(3) {
        for (int item_ = bx; item_ < 256 * RMUL(3); item_ += G) {
            const int item = item_ & 255;
            __syncthreads();
            {
                const int t0 = item * 64;
                bf16* Al = (bf16*)lds;
                bf16* Ks = (bf16*)(lds + 40960);
                const float* mu = args.in[11];
                {
                    const int tl = tid >> 3, cb = (tid & 7) * 36; const int t = t0 + tl; const bool first = (t & (SEQ - 1)) == 0;
                    const bf16* cur = P + (size_t)t * NINP + 2048 + 3072 + cb; const bf16* prv = cur - NINP;
#pragma unroll 6
                    for (int q = 0; q < 18; ++q) { const unsigned c2 = *(const unsigned*)(cur + 2 * q); const unsigned p2 = first ? 0u : *(const unsigned*)(prv + 2 * q);
                        const int c = cb + 2 * q; const float m0 = mu[3072 + c], m1 = mu[3072 + c + 1];
                        float v0 = bf_lo(c2), v1 = bf_hi(c2); v0 += (bf_lo(p2) - v0) * m0; v1 += (bf_hi(p2) - v1) * m1;
                        if (c < 64) { v0 = tanh_fast(v0); v1 = tanh_fast(v1); } else if (c >= 128) { v0 = sigmoid1(v0); v1 = sigmoid1(v1); }
                        *(unsigned*)(Al + tl * 296 + c) = pk2(v0, v1); }
                }
                const int c0 = wave * 128;
                const float* w0p = args.in[12]; const float* a0p = args.in[14]; const float* kkw = args.in[17]; const float* kaw = args.in[18];
#define RW_ZERO() do { _Pragma("unroll") for (int b_ = 0; b_ < 4; ++b_) _Pragma("unroll") for (int r_ = 0; r_ < 16; ++r_) acc[b_][r_] = 0.f; } while (0)
#define RW_MM(BT, KB, ACOL, NKS) do { _Pragma("unroll 2") for (int ks = 0; ks < (NKS); ++ks) { bf16x8 bfr[4]; \
        const bf16x8 af = *(const bf16x8*)(Al + (mt * 32 + (lane & 31)) * 296 + (ACOL) + ks * 16 + (lane >> 5) * 8); \
        _Pragma("unroll") for (int b_ = 0; b_ < 4; ++b_) bfr[b_] = *(const bf16x8*)((BT) + (size_t)(c0 + b_ * 32 + (lane & 31)) * (KB) + ks * 16 + (lane >> 5) * 8); \
        _Pragma("unroll") for (int b_ = 0; b_ < 4; ++b_) acc[b_] = __builtin_amdgcn_mfma_f32_32x32x16_bf16(af, bfr[b_], acc[b_], 0, 0, 0); } } while (0)
#pragma unroll 1
                for (int mt = 0; mt < 2; ++mt) {
                    __syncthreads();
#pragma unroll 6
                    for (int op = tid; op < 3 * 32 * 128; op += NT) {
                        const int which = op >> 12, tl = (op >> 7) & 31, c8 = (op & 127) * 8; const int t = t0 + mt * 32 + tl; const bool first = (t & (SEQ - 1)) == 0;
                        const bf16* cp = P + (size_t)t * NINP + 2048 + which * 1024 + c8;
                        const u32x4 cu = *(const u32x4*)cp; u32x4 pr = (u32x4){0u, 0u, 0u, 0u}; if (!first) pr = *(const u32x4*)(cp - NINP);
                        const f32x4 m0 = *(const f32x4*)(mu + which * 1024 + c8), m1 = *(const f32x4*)(mu + which * 1024 + c8 + 4);
                        u32x4 o;
                        { float a = bf_lo(cu.x), b = bf_hi(cu.x); a += (bf_lo(pr.x) - a) * m0.x; b += (bf_hi(pr.x) - b) * m0.y; o.x = pk2(a, b); }
                        { float a = bf_lo(cu.y), b = bf_hi(cu.y); a += (bf_lo(pr.y) - a) * m0.z; b += (bf_hi(pr.y) - b) * m0.w; o.y = pk2(a, b); }
                        { float a = bf_lo(cu.z), b = bf_hi(cu.z); a += (bf_lo(pr.z) - a) * m1.x; b += (bf_hi(pr.z) - b) * m1.y; o.z = pk2(a, b); }
                        { float a = bf_lo(cu.w), b = bf_hi(cu.w); a += (bf_lo(pr.w) - a) * m1.z; b += (bf_hi(pr.w) - b) * m1.w; o.w = pk2(a, b); }
                        if (which == 0) *(u32x4*)(RR + (size_t)t * 1024 + c8) = o;
                        else if (which == 2) *(u32x4*)(VV + (size_t)t * 1024 + c8) = o;
                        else *(u32x4*)(Ks + tl * 1032 + c8) = o;
                    }
                    __syncthreads();
                    f32x16 acc[4];
                    RW_ZERO(); RW_MM(W2T, 64, 0, 4);
#pragma unroll
                    for (int nt = 0; nt < 4; ++nt) { const int col = c0 + nt * 32 + (lane & 31); const float w0v = w0p[col];
#pragma unroll
                        for (int r = 0; r < 16; ++r) { const int t = t0 + mt * 32 + (r & 3) + 8 * (r >> 2) + 4 * (lane >> 5);
                            const float sg = sigmoid1(w0v + acc[nt][r]);
                            DEC[(size_t)t * 1024 + col] = __expf(-0.60653065971f * sg); }
                        asm volatile("" ::: "memory"); }
                    RW_ZERO(); RW_MM(A2T, 64, 64, 4);
#pragma unroll
                    for (int hh = 0; hh < 2; ++hh) {
                        const int colA = c0 + hh * 64 + (lane & 31), colB = colA + 32;
                        const float a0A = a0p[colA], a0B = a0p[colB], kkA = kkw[colA], kkB = kkw[colB], kaA = kaw[colA], kaB = kaw[colB];
#pragma unroll
                        for (int r = 0; r < 16; ++r) { const int tl = (r & 3) + 8 * (r >> 2) + 4 * (lane >> 5); const int t = t0 + mt * 32 + tl;
                            const float kA = bf1(Ks[tl * 1032 + colA]), kB = bf1(Ks[tl * 1032 + colB]);
                            const float aA = sigmoid1(a0A + acc[hh * 2][r]), aB = sigmoid1(a0B + acc[hh * 2 + 1][r]);
                            const float qA = kA * kkA, qB = kB * kkB;
                            const float ss = half32_sum(qA * qA + qB * qB);
                            const float inv = __builtin_amdgcn_rsqf(fmaxf(ss, 1e-24f));
                            const float nA = qA * inv, nB = qB * inv;
                            const size_t oA = (size_t)t * 1024 + colA, oB = oA + 32;
                            KP[oA] = f2bf(kA * (1.0f + (aA - 1.0f) * kaA)); KP[oB] = f2bf(kB * (1.0f + (aB - 1.0f) * kaB));
                            KKn[oA] = f2bf(nA); KKn[oB] = f2bf(nB); BB[oA] = f2bf(nA * aA); BB[oB] = f2bf(nB * aB);
                            if ((r & 3) == 3) asm volatile("" ::: "memory"); }
                    }
                    RW_ZERO(); RW_MM(G2T, 160, 128, 10);
#pragma unroll
                    for (int nt = 0; nt < 4; ++nt) { const int col = c0 + nt * 32 + (lane & 31);
#pragma unroll
                        for (int r = 0; r < 16; ++r) { const int t = t0 + mt * 32 + (r & 3) + 8 * (r >> 2) + 4 * (lane >> 5);
                            GG[(size_t)t * 1024 + col] = f2bf(acc[nt][r]); }
                        asm volatile("" ::: "memory"); }
                }
            }
        }
#undef RW_ZERO
#undef RW_MM
        for (int item_ = bx; item_ < 256 * RMUL(3); item_ += G) {
            const int item = item_ & 255;
            __syncthreads();
            {
                const int T0 = (item >> 1) * 128, hg = (item & 1) * 4;
                bf16* VnT = (bf16*)lds;
                f32x2* st = (f32x2*)(lds + 36864);
                const float* vg = args.in[6]; const float* vb = args.in[7]; const float* wsp = args.in[8]; const float* bs = args.in[9];
#pragma unroll 1
                for (int i0 = 0; i0 < 16; i0 += 4) {
                    u32x4 a[4], b[4];
#pragma unroll
                    for (int i = 0; i < 4; ++i) { const bf16* row = P + (size_t)(T0 + wave * 16 + i0 + i) * NINP + 1024; a[i] = *(const u32x4*)(row + lane * 8); b[i] = *(const u32x4*)(row + 512 + lane * 8); }
#pragma unroll
                    for (int i = 0; i < 4; ++i) { float s = 0.f, s2 = 0.f;
#pragma unroll
                        for (int q = 0; q < 4; ++q) { const float v0 = bf_lo(a[i][q]), v1 = bf_hi(a[i][q]), v2 = bf_lo(b[i][q]), v3 = bf_hi(b[i][q]); s += (v0 + v1) + (v2 + v3); s2 += (v0 * v0 + v1 * v1) + (v2 * v2 + v3 * v3); }
                        s = wave_sum(s); s2 = wave_sum(s2);
                        const float mean = s * (1.0f / 1024.0f); const float var = fmaxf(s2 * (1.0f / 1024.0f) - mean * mean, 0.f);
                        if (lane == 0) st[wave * 16 + i0 + i] = (f32x2){mean, rsqrtf(var + 1e-5f)}; }
                }
                for (int hh = 0; hh < 4; ++hh) {
                    const int h = hg + hh;
                    __syncthreads();
                    {
                        const int j = tid >> 2, d0 = (tid & 3) * 32; const f32x2 sj = st[j];
                        const bf16* src = P + (size_t)(T0 + j) * NINP + 1024 + h * 128 + d0;
                        u32x4 a[4];
#pragma unroll
                        for (int q = 0; q < 4; ++q) a[q] = *(const u32x4*)(src + q * 8);
#pragma unroll
                        for (int q = 0; q < 4; ++q) {
#pragma unroll
                            for (int e = 0; e < 4; ++e) { const int d = d0 + q * 8 + e * 2; const int col = h * 128 + d;
                                const float v0 = (bf_lo(a[q][e]) - sj.x) * sj.y * vg[col] + vb[col], v1 = (bf_hi(a[q][e]) - sj.x) * sj.y * vg[col + 1] + vb[col + 1];
                                VnT[d * 136 + j] = f2bf(v0); VnT[(d + 1) * 136 + j] = f2bf(v1); } }
                    }
                    __syncthreads();
                    const int it_ = wave >> 1, dt0 = (wave & 1) * 2, nks = (it_ < 2) ? 4 : 8;
                    bf16 gu[2][16];
#pragma unroll
                    for (int q = 0; q < 2; ++q)
#pragma unroll
                        for (int r = 0; r < 16; ++r) { const int i = it_ * 32 + (r & 3) + 8 * (r >> 2) + 4 * (lane >> 5), d = (dt0 + q) * 32 + (lane & 31);
                            gu[q][r] = P[(size_t)(T0 + i) * NINP + h * 128 + d]; }
                    f32x16 acc[2];
#pragma unroll
                    for (int q = 0; q < 2; ++q)
#pragma unroll
                        for (int r = 0; r < 16; ++r) acc[q][r] = 0.f;
                    const float* wrow = wsp + ((size_t)h * 128 + it_ * 32 + (lane & 31)) * 128 + (lane >> 5) * 8;
#pragma unroll 2
                    for (int ks = 0; ks < nks; ++ks) {
                        const f32x4 w0 = *(const f32x4*)(wrow + ks * 16), w1 = *(const f32x4*)(wrow + ks * 16 + 4);
                        u32x4 au; au.x = pk2(w0.x, w0.y); au.y = pk2(w0.z, w0.w); au.z = pk2(w1.x, w1.y); au.w = pk2(w1.z, w1.w);
                        const bf16x8 af = __builtin_bit_cast(bf16x8, au);
#pragma unroll
                        for (int q = 0; q < 2; ++q) { const bf16x8 bfr = *(const bf16x8*)(VnT + ((dt0 + q) * 32 + (lane & 31)) * 136 + ks * 16 + (lane >> 5) * 8);
                            acc[q] = __builtin_amdgcn_mfma_f32_32x32x16_bf16(af, bfr, acc[q], 0, 0, 0); }
                    }
#pragma unroll
                    for (int q = 0; q < 2; ++q)
#pragma unroll
                        for (int r = 0; r < 16; ++r) { const int i = it_ * 32 + (r & 3) + 8 * (r >> 2) + 4 * (lane >> 5), d = (dt0 + q) * 32 + (lane & 31);
                            const float z = acc[q][r] + bs[h * 128 + i];
                            HB[(size_t)(T0 + i) * DM + h * 128 + d] = f2bf(bf1(gu[q][r]) * z); }
                }
            }
        }
    }
    SEAM(3);

    if (IN(4)) {
        constexpr int TC = 32, BUF = 45056;
        float* yp = (float*)(lds + BUF);
#define LDS_BARRIER() do { asm volatile("s_waitcnt lgkmcnt(0)" ::: "memory"); __builtin_amdgcn_s_barrier(); asm volatile("" ::: "memory"); } while (0)
        for (int task_ = bx; task_ < 256 * RMUL(4); task_ += G) {
            const int task = task_ & 255; const int bh = task >> 1, half = task & 1, b = bh >> 4, h = bh & 15;
            const int stp = tid >> 4, q = tid & 15;
            const size_t base = ((size_t)b * SEQ + stp) * 1024 + h * 64;
            f32x4 ld_dec; u32x2 ld_kk, ld_bb, ld_kp, ld_rr; unsigned ld_vv;
#define SC_LOAD(tc) do { const size_t o_ = base + (size_t)(tc) * 1024 + q * 4; ld_dec = *(const f32x4*)(DEC + o_); ld_kk = *(const u32x2*)(KKn + o_); ld_bb = *(const u32x2*)(BB + o_); \
            ld_kp = *(const u32x2*)(KP + o_); ld_rr = *(const u32x2*)(RR + o_); ld_vv = *(const unsigned*)(VV + base + (size_t)(tc) * 1024 + half * 32 + q * 2); } while (0)
#define SC_STORE() do { float* B_ = (float*)lds; const int o_ = stp * 64 + q * 4; *(f32x4*)(B_ + o_) = ld_dec; \
            *(f32x4*)(B_ + 2048 + o_) = (f32x4){-bf_lo(ld_kk.x), -bf_hi(ld_kk.x), -bf_lo(ld_kk.y), -bf_hi(ld_kk.y)}; \
            *(f32x4*)(B_ + 4096 + o_) = (f32x4){bf_lo(ld_bb.x), bf_hi(ld_bb.x), bf_lo(ld_bb.y), bf_hi(ld_bb.y)}; \
            *(f32x4*)(B_ + 6144 + o_) = (f32x4){bf_lo(ld_kp.x), bf_hi(ld_kp.x), bf_lo(ld_kp.y), bf_hi(ld_kp.y)}; \
            *(f32x4*)(B_ + 8192 + o_) = (f32x4){bf_lo(ld_rr.x), bf_hi(ld_rr.x), bf_lo(ld_rr.y), bf_hi(ld_rr.y)}; \
            *(f32x2*)(B_ + 10240 + stp * 32 + q * 2) = (f32x2){bf_lo(ld_vv), bf_hi(ld_vv)}; } while (0)
            __syncthreads();
            SC_LOAD(0); SC_STORE();
            __syncthreads();
            f32x4 S = (f32x4){0.f, 0.f, 0.f, 0.f};
            const int row = wave * 4 + (lane >> 4), kl = lane & 15;
            const float* B_ = (const float*)lds;
            for (int c = 0; c < SEQ / TC; ++c) {
                if (c + 1 < SEQ / TC) SC_LOAD((c + 1) * TC);
#define SC_LD(W, A, Bv, K, R, V, s_) do { const float* p_ = B_ + (s_) * 64 + kl * 4; W = *(const f32x4*)p_; A = *(const f32x4*)(p_ + 2048); Bv = *(const f32x4*)(p_ + 4096); K = *(const f32x4*)(p_ + 6144); R = *(const f32x4*)(p_ + 8192); V = B_[10240 + (s_) * 32 + row]; } while (0)
#define SC_STEP(W, A, Bv, K, R, V, s_) do { float sa_ = S.x * A.x; sa_ = fmaf(S.y, A.y, sa_); sa_ = fmaf(S.z, A.z, sa_); sa_ = fmaf(S.w, A.w, sa_); \
                    sa_ = row16_sum(sa_); S = S * W + Bv * sa_ + K * V; \
                    float y_ = S.x * R.x; y_ = fmaf(S.y, R.y, y_); y_ = fmaf(S.z, R.z, y_); y_ = fmaf(S.w, R.w, y_); yp[((s_) * 32 + row) * 16 + kl] = y_; } while (0)
                f32x4 w0, a0, b0, k0, r0, w1, a1, b1, k1, r1; float v0, v1;
                SC_LD(w0, a0, b0, k0, r0, v0, 0);
#pragma unroll 2
                for (int s = 0; s < TC; s += 2) {
                    SC_LD(w1, a1, b1, k1, r1, v1, s + 1);
                    SC_STEP(w0, a0, b0, k0, r0, v0, s);
                    if (s + 2 < TC) SC_LD(w0, a0, b0, k0, r0, v0, s + 2);
                    SC_STEP(w1, a1, b1, k1, r1, v1, s + 1);
                }
#undef SC_LD
#undef SC_STEP
                LDS_BARRIER();
#pragma unroll
                for (int o2 = 0; o2 < 2; ++o2) {
                    const int oi = tid + o2 * NT; const float* pp = yp + oi * 16; const f32x4 p0 = *(const f32x4*)pp, p1 = *(const f32x4*)(pp + 4), p2 = *(const f32x4*)(pp + 8), p3 = *(const f32x4*)(pp + 12);
                    const f32x4 t = (p0 + p1) + (p2 + p3);
                    Y[((size_t)b * SEQ + c * TC + (oi >> 5)) * 1024 + h * 64 + half * 32 + (oi & 31)] = (t.x + t.y) + (t.z + t.w); }
                if (c + 1 < SEQ / TC) SC_STORE();
                LDS_BARRIER();
            }
#undef SC_LOAD
#undef SC_STORE
        }
#undef LDS_BARRIER
    }
    SEAM(4);

    if (IN(5)) {
        const float* rk = args.in[19]; const float* lng = args.in[20]; const float* lnb = args.in[21]; const float* og = args.in[10];
        for (int t_ = gw; t_ < MTOK * RMUL(5); t_ += NGW) { const int t = t_ & (MTOK - 1);
            const size_t o = (size_t)t * 1024 + lane * 16;
            f32x4 y[4];
#pragma unroll
            for (int j = 0; j < 4; ++j) y[j] = *(const f32x4*)(Y + o + 4 * j);
            float s = 0.f;
#pragma unroll
            for (int j = 0; j < 4; ++j) s += (y[j].x + y[j].y) + (y[j].z + y[j].w);
            s = quad_sum(s); const float mean = s * (1.0f / 64.0f);
            float s2 = 0.f;
#pragma unroll
            for (int j = 0; j < 4; ++j) { y[j] = y[j] - mean; s2 += (y[j].x * y[j].x + y[j].y * y[j].y) + (y[j].z * y[j].z + y[j].w * y[j].w); }
            s2 = quad_sum(s2); const float rstd = rsqrtf(s2 * (1.0f / 64.0f) + 64e-5f);
            u32x4 r8[2], k8[2], v8[2], g8[2];
#pragma unroll
            for (int j = 0; j < 2; ++j) { r8[j] = *(const u32x4*)(RR + o + 8 * j); k8[j] = *(const u32x4*)(KP + o + 8 * j); v8[j] = *(const u32x4*)(VV + o + 8 * j); g8[j] = *(const u32x4*)(GG + o + 8 * j); }
            float dp = 0.f;
#pragma unroll
            for (int j = 0; j < 2; ++j)
#pragma unroll
                for (int e = 0; e < 4; ++e) { const int col = lane * 16 + j * 8 + e * 2; dp += bf_lo(r8[j][e]) * bf_lo(k8[j][e]) * rk[col] + bf_hi(r8[j][e]) * bf_hi(k8[j][e]) * rk[col + 1]; }
            dp = quad_sum(dp);
            u32x4 ov[2];
#pragma unroll
            for (int j = 0; j < 2; ++j)
#pragma unroll
                for (int e = 0; e < 4; ++e) { const int c = j * 8 + e * 2; const int col = lane * 16 + c;
                    const float y0 = y[c >> 2][c & 3], y1 = y[(c + 1) >> 2][(c + 1) & 3];
                    const float o0 = (y0 * rstd * lng[col] + lnb[col] + dp * bf_lo(v8[j][e])) * bf_lo(g8[j][e]);
                    const float o1 = (y1 * rstd * lng[col + 1] + lnb[col + 1] + dp * bf_hi(v8[j][e])) * bf_hi(g8[j][e]);
                    ov[j][e] = pk2(o0, o1); }
            bf16* op = HB + (size_t)t * DM + 1024 + lane * 16;
            *(u32x4*)op = ov[0]; *(u32x4*)(op + 8) = ov[1];
            {
                bf16* ap = HB + (size_t)t * DM + lane * 16; u32x4 ya[2]; ya[0] = *(const u32x4*)ap; ya[1] = *(const u32x4*)(ap + 8);
                float q2 = 0.f;
#pragma unroll
                for (int j = 0; j < 2; ++j)
#pragma unroll
                    for (int e = 0; e < 4; ++e) { const float v0 = bf_lo(ya[j][e]), v1 = bf_hi(ya[j][e]); q2 += v0 * v0 + v1 * v1; }
                q2 = wave_sum(q2);
                const float ri = rsqrtf(q2 * (1.0f / 1024.0f) + 1e-6f);
#pragma unroll
                for (int j = 0; j < 2; ++j)
#pragma unroll
                    for (int e = 0; e < 4; ++e) { const int col = lane * 16 + j * 8 + e * 2; ya[j][e] = pk2(bf_lo(ya[j][e]) * ri * og[col], bf_hi(ya[j][e]) * ri * og[col + 1]); }
                *(u32x4*)ap = ya[0]; *(u32x4*)(ap + 8) = ya[1];
            }
        }
    }
    SEAM(5);

    if (IN(6)) {
        pg8::Gemm g{HB, WOUT, MTOK, DM, DM}; pg8::StaticOrder S; S.init(MTOK, DM, G, bx, RMUL(6));
        pg8::EpiRes E{x, args.out, MOD + 2 * DM, NMODC};
        pg8::gemm_phase<pg8::EpiRes, pg8::StaticOrder, true, true>((PG8_LAS unsigned char*)lds, g, S, E);
    }
    SEAM(6);

    if (IN(7)) norm_mod_rows(args.out, args.in[23], MOD, 3, 4, HB, gw, NGW, lane);
    SEAM(7);

    if (IN(8)) {
        pg8::Gemm g{HB, WQ, MTOK, DM, DM}; pg8::StaticOrder S; S.init(MTOK, DM, G, bx);
        pg8::EpiBf16G E{Q, DM, 0};
        pg8::gemm_phase<pg8::EpiBf16G, pg8::StaticOrder, true, true>((PG8_LAS unsigned char*)lds, g, S, E);
    }
    SEAM(8);

    if (IN(9)) REPS(9) {
        float* scr = (float*)(lds + wave * 8704);
        for (int task_ = gw; task_ < (MTOK / 64) * 8 * RMUL(9); task_ += NGW) {
            const int task = task_ & 2047; const int tt = task >> 3, h = task & 7;
            int T0[16], T1[16];
#pragma unroll
            for (int p = 0; p < 2; ++p) {
                int T[16];
#pragma unroll
                for (int j = 0; j < 16; ++j) T[j] = (int)0xff7fffff;
                const bf16* qa = Q + (size_t)(tt * 64 + (lane & 31)) * DM + h * 256 + p * 128 + (lane >> 5) * 8;
                for (int nc = 0; nc < 4; ++nc) {
                    f32x16 acc[2];
#pragma unroll
                    for (int mt = 0; mt < 2; ++mt)
#pragma unroll
                        for (int r = 0; r < 16; ++r) acc[mt][r] = 0.f;
                    const bf16* kb = KEYSB + ((size_t)(h * 2 + p) * 128 + nc * 32 + (lane & 31)) * 128 + (lane >> 5) * 8;
#pragma unroll
                    for (int ks = 0; ks < 8; ++ks) { const bf16x8 bfr = *(const bf16x8*)(kb + ks * 16);
                        const bf16x8 af0 = *(const bf16x8*)(qa + ks * 16), af1 = *(const bf16x8*)(qa + (size_t)32 * DM + ks * 16);
                        acc[0] = __builtin_amdgcn_mfma_f32_32x32x16_bf16(af0, bfr, acc[0], 0, 0, 0);
                        acc[1] = __builtin_amdgcn_mfma_f32_32x32x16_bf16(af1, bfr, acc[1], 0, 0, 0); }
#pragma unroll
                    for (int mt = 0; mt < 2; ++mt)
#pragma unroll
                        for (int r = 0; r < 16; ++r) scr[(mt * 32 + (r & 3) + 8 * (r >> 2) + 4 * (lane >> 5)) * 33 + (lane & 31)] = acc[mt][r];
                    asm volatile("s_waitcnt lgkmcnt(0)" ::: "memory");
#pragma unroll 4
                    for (int j = 0; j < 32; ++j) {
                        int key = (__float_as_int(scr[lane * 33 + j]) & ~127) | (127 - (nc * 32 + j));
#pragma unroll
                        for (int u = 0; u < 16; u += 2) {
                            const int t0_ = T[u], t1_ = T[u + 1]; T[u] = kmax(t0_, key); T[u + 1] = kmed3(t0_, t1_, key); key = kmin(t1_, key); }
                    }
                    asm volatile("s_waitcnt lgkmcnt(0)" ::: "memory");
                }
#pragma unroll
                for (int j = 0; j < 16; ++j) { if (p == 0) T0[j] = T[j]; else T1[j] = T[j]; }
            }
            float tv[16]; int te[16];
#pragma unroll
            for (int j = 0; j < 16; ++j) { tv[j] = -3.0e38f; te[j] = 0; }
#pragma unroll
            for (int i = 0; i < 16; ++i)
#pragma unroll
                for (int j = 0; j < 16; ++j) if ((i + 1) * (j + 1) <= 16) {
                    const int m0 = T0[i] & ~127, m1 = T1[j] & ~127;
                    const float s0 = __int_as_float(m0), s1 = __int_as_float(m1);
                    float fv = s0 + s1; int pe = ((127 - (T0[i] & 127)) << 7) | (127 - (T1[j] & 127));
#pragma unroll
                    for (int u = (i + 1) * (j + 1) - 1; u < 16; ++u) { const bool c = fv > tv[u]; const float nv = c ? fv : tv[u]; const int ne = c ? pe : te[u]; fv = c ? tv[u] : fv; pe = c ? te[u] : pe; tv[u] = nv; te[u] = ne; }
                }
            {
                const float mx = tv[0]; float sum = 0.f;
#pragma unroll
                for (int j = 0; j < 16; ++j) { tv[j] = __expf(tv[j] - mx); sum += tv[j]; }
                const float inv = 1.0f / sum;
#pragma unroll
                for (int j = 0; j < 16; ++j) tv[j] *= inv;
            }
            const size_t o = (size_t)(tt * 64 + lane) * 128 + h * 16;
#pragma unroll
            for (int j = 0; j < 16; ++j) { EIDX[o + j] = te[j]; GATE[o + j] = tv[j]; }
        }
        CONVERT_EXPERT_FP4_ROWS(args.in[27], PV8, SCL + 16384, gw, NGW);
    }
    SEAM(9);

    if (IN(10)) {
        const float* fg = args.in[28];
        for (int tok = gw; tok < MTOK; tok += NGW) {
            const int b = tok >> 11;
            f32x2 hf2[16];
#pragma unroll
            for (int j = 0; j < 4; ++j) { const u32x4 a = *(const u32x4*)(HB + (size_t)tok * DM + lane * 32 + j * 8);
#pragma unroll
                for (int q = 0; q < 4; ++q) hf2[j * 4 + q] = (f32x2){bf_lo(a[q]), bf_hi(a[q])}; }
            const int e0 = EIDX[(size_t)tok * 128 + lane], e1 = EIDX[(size_t)tok * 128 + 64 + lane];
            const float g0 = GATE[(size_t)tok * 128 + lane], g1 = GATE[(size_t)tok * 128 + 64 + lane];
            const bool hi32 = (lane & 32) != 0, hi16 = (lane & 16) != 0; const int l3 = (lane & 3) << 4;
#define PU_LOAD(BUF, EV, S0) do { _Pragma("unroll") for (int i = 0; i < 8; ++i) { const int row_ = __builtin_amdgcn_readlane(EV, (S0) + i); BUF[i & 3][i >> 2] = *(const u32x4*)(PU8 + (size_t)row_ * 1024 + lane * 16); } } while (0)
#define PU_DOT4(BUF, H, S0) do { float d_[4]; _Pragma("unroll") for (int i = 0; i < 4; ++i) { f32x2 da_ = (f32x2){0.f, 0.f}; \
        _Pragma("unroll") for (int q = 0; q < 4; ++q) { const unsigned w_ = BUF[i][H][q]; \
            da_ = __builtin_elementwise_fma(__builtin_amdgcn_cvt_scalef32_pk_f32_fp4(w_, 1.0f, 0), hf2[q * 4 + 0], da_); da_ = __builtin_elementwise_fma(__builtin_amdgcn_cvt_scalef32_pk_f32_fp4(w_, 1.0f, 1), hf2[q * 4 + 1], da_); \
            da_ = __builtin_elementwise_fma(__builtin_amdgcn_cvt_scalef32_pk_f32_fp4(w_, 1.0f, 2), hf2[q * 4 + 2], da_); da_ = __builtin_elementwise_fma(__builtin_amdgcn_cvt_scalef32_pk_f32_fp4(w_, 1.0f, 3), hf2[q * 4 + 3], da_); } d_[i] = da_.x + da_.y; } \
        float k0_ = hi32 ? d_[2] : d_[0], k1_ = hi32 ? d_[3] : d_[1]; const float s0_ = hi32 ? d_[0] : d_[2], s1_ = hi32 ? d_[1] : d_[3]; \
        k0_ += __shfl_xor(s0_, 32); k1_ += __shfl_xor(s1_, 32); float k_ = hi16 ? k1_ : k0_; const float s_ = hi16 ? k0_ : k1_; k_ += __shfl_xor(s_, 16); k_ = row16_sum(k_); \
        const float t_ = __shfl(k_, l3); if ((lane >> 2) == ((S0) >> 2)) dv = t_; } while (0)
            float act0 = 0.f, act1 = 0.f;
            u32x4 bA[4][2], bB[4][2];
#pragma unroll
            for (int hh = 0; hh < 2; ++hh) {
                const int ev = hh ? e1 : e0; const float gv = hh ? g1 : g0; float dv = 0.f;
                PU_LOAD(bA, ev, 0);
#pragma unroll 1
                for (int s = 0; s < 64; s += 16) {
                    PU_LOAD(bB, ev, s + 8);
                    PU_DOT4(bA, 0, s); PU_DOT4(bA, 1, s + 4);
                    if (s + 16 < 64) PU_LOAD(bA, ev, s + 16);
                    PU_DOT4(bB, 0, s + 8); PU_DOT4(bB, 1, s + 12);
                }
                const float d = dv * SCL[ev];
                const float a = gelu1(d) * gv * SCL[16384 + ev];
                if (hh) act1 = a; else act0 = a;
            }
#undef PU_LOAD
#undef PU_DOT4
            f32x2 acc2[16];
#pragma unroll
            for (int i = 0; i < 16; ++i) acc2[i] = (f32x2){0.f, 0.f};
#define PV_LOAD(BUF, EV, S0) do { _Pragma("unroll") for (int i = 0; i < 8; ++i) { const int row_ = __builtin_amdgcn_readlane(EV, (S0) + i); BUF[i & 3][i >> 2] = *(const u32x4*)(PV8 + (size_t)row_ * 1024 + lane * 16); } } while (0)
#define PV_ACC(BUF, AV, S0) do { _Pragma("unroll") for (int i = 0; i < 8; ++i) { const float a_ = __int_as_float(__builtin_amdgcn_readlane(__float_as_int(AV), (S0) + i)); const f32x2 a2_ = (f32x2){a_, a_}; \
        _Pragma("unroll") for (int q = 0; q < 4; ++q) { const unsigned w_ = BUF[i & 3][i >> 2][q]; \
            acc2[q * 4 + 0] = __builtin_elementwise_fma(a2_, __builtin_amdgcn_cvt_scalef32_pk_f32_fp4(w_, 1.0f, 0), acc2[q * 4 + 0]); acc2[q * 4 + 1] = __builtin_elementwise_fma(a2_, __builtin_amdgcn_cvt_scalef32_pk_f32_fp4(w_, 1.0f, 1), acc2[q * 4 + 1]); \
            acc2[q * 4 + 2] = __builtin_elementwise_fma(a2_, __builtin_amdgcn_cvt_scalef32_pk_f32_fp4(w_, 1.0f, 2), acc2[q * 4 + 2]); acc2[q * 4 + 3] = __builtin_elementwise_fma(a2_, __builtin_amdgcn_cvt_scalef32_pk_f32_fp4(w_, 1.0f, 3), acc2[q * 4 + 3]); } } } while (0)
#pragma unroll
            for (int hh = 0; hh < 2; ++hh) {
                const int ev = hh ? e1 : e0; const float av = hh ? act1 : act0;
                PV_LOAD(bA, ev, 0);
#pragma unroll 1
                for (int s = 0; s < 64; s += 16) {
                    PV_LOAD(bB, ev, s + 8);
                    PV_ACC(bA, av, s);
                    if (s + 16 < 64) PV_LOAD(bA, ev, s + 16);
                    PV_ACC(bB, av, s + 8);
                }
            }
#undef PV_LOAD
#undef PV_ACC
            float acc[32];
#pragma unroll
            for (int i = 0; i < 16; ++i) { acc[2 * i] = acc2[i].x; acc[2 * i + 1] = acc2[i].y; }
            float* xr = args.out + (size_t)tok * DM + lane * 32; const float* gt2 = MOD + (size_t)b * NMODC + 5 * DM + lane * 32;
            float ss = 0.f;
#pragma unroll
            for (int q = 0; q < 8; ++q) { const f32x4 xv = *(const f32x4*)(xr + q * 4), g4 = *(const f32x4*)(gt2 + q * 4);
                float* a = acc + q * 4;
                a[0] = xv.x + g4.x * a[0]; a[1] = xv.y + g4.y * a[1]; a[2] = xv.z + g4.z * a[2]; a[3] = xv.w + g4.w * a[3];
                ss += (a[0] * a[0] + a[1] * a[1]) + (a[2] * a[2] + a[3] * a[3]); }
            ss = wave_sum(ss);
            const float rinv = rsqrtf(ss * (1.0f / DM) + 1e-6f);
#pragma unroll
            for (int q = 0; q < 8; ++q) { const f32x4 f4 = *(const f32x4*)(fg + lane * 32 + q * 4); const float* a = acc + q * 4;
                *(f32x4*)(xr + q * 4) = (f32x4){a[0] * rinv * f4.x, a[1] * rinv * f4.y, a[2] * rinv * f4.z, a[3] * rinv * f4.w}; }
        }
    }
#undef IN
#undef SEAM
}

extern "C" void kernel_launch(void* const* d_in, const int* in_sizes, int n_in, void* d_out, int out_size, void* d_ws, size_t ws_size, hipStream_t stream) {
    static int grid = 0;
    if (grid == 0) {
        if (n_in != 29 || ws_size < WS_END) { fprintf(stderr, "kernel_launch: unexpected n_in %d / ws %zu\n", n_in, ws_size); grid = -1; return; }
        int dev = 0, cus = 0, per_cu = 0;
        hipGetDevice(&dev); hipDeviceGetAttribute(&cus, hipDeviceAttributeMultiprocessorCount, dev);
        hipFuncSetAttribute((const void*)mk_fwd, hipFuncAttributeMaxDynamicSharedMemorySize, LDS_BYTES);
        hipOccupancyMaxActiveBlocksPerMultiprocessor(&per_cu, (const void*)mk_fwd, NT, LDS_BYTES);
        if (per_cu < 1) { fprintf(stderr, "kernel_launch: occupancy query says %d\n", per_cu); per_cu = 1; }
        if (per_cu > 1) per_cu = 1;
        grid = cus * per_cu;
        (void)hipGetLastError();
    }
    if (grid < 0) return;
    Args a{};
    for (int i = 0; i < 29; ++i) a.in[i] = (const float*)d_in[i];
    a.out = (float*)d_out; a.ws = (unsigned char*)d_ws;
#if MK_ONE_LAUNCH
    (void)hipMemsetAsync(d_ws, 0, CTL_ZERO_BYTES, stream);
    a.ph_lo = 0; a.ph_hi = NPHASE;
    void* kargs[] = {&a};
    hipError_t e = hipLaunchCooperativeKernel((const void*)mk_fwd, dim3(grid), dim3(NT), kargs, LDS_BYTES, stream);
    if (e != hipSuccess) fprintf(stderr, "cooperative launch failed: %s (grid %d)\n", hipGetErrorString(e), grid);
#else
    for (int p = 0; p < NPHASE; ++p) { a.ph_lo = p; a.ph_hi = p + 1; hipLaunchKernelGGL(mk_fwd, dim3(grid), dim3(NT), LDS_BYTES, stream, a); }
#endif
}
```

```cpp
#include <hip/hip_runtime.h>
#include <hip/hip_cooperative_groups.h>
#include <cstdio>
#include <cstdint>
namespace cg = cooperative_groups;

#ifndef MK_ONE_LAUNCH
#define MK_ONE_LAUNCH 1
#endif

namespace pg8 {
#define PG8_LAS __attribute__((address_space(3)))
typedef unsigned short bf16_t;
typedef short bf16x8 __attribute__((ext_vector_type(8)));
typedef float f32x4 __attribute__((ext_vector_type(4)));
typedef float f32x2 __attribute__((ext_vector_type(2)));
typedef unsigned u32x4 __attribute__((ext_vector_type(4)));
constexpr int BM = 256, BK = 64, HALF = 128, HTB = HALF * BK * 2, STAGE_BYTES = 8 * HTB, NXCD = 8, WGM = 8;

__host__ __device__ __forceinline__ int lds_byte(int r, int c) { const int st = (r >> 4) * 2 + (c >> 5), rr = r & 15, cc = c & 31, ob = rr * 64 + cc * 2; return st * 1024 + (ob ^ (((ob >> 9) & 1) << 5)); }
__host__ __device__ __forceinline__ void stage_rc(int b, int& R, int& C) { const int st = b / 1024, sb = b % 1024, swz = sb ^ (((sb >> 9) & 1) << 5); R = (st >> 1) * 16 + swz / 64; C = (st & 1) * 32 + (swz % 64) / 2; }
__host__ __device__ __forceinline__ int perm32(int rho) { const int n = rho >> 4, i = rho & 15; return 8 * (i >> 2) + 4 * n + (i & 3); }

struct Unit { int pm, pn; };
struct Gemm { const bf16_t* A; const bf16_t* Bt; int M, N, K; };

struct StaticOrder {
    int nM, nN, nwg, G, c, rep;
    __host__ __device__ void init(int M, int N, int G_, int c_, int rep_ = 1) { nM = M / BM; nN = N / BM; nwg = nM * nN; G = G_; c = c_; rep = rep_; }
    __host__ __device__ bool next(int i, Unit& u) const {
        const long L = (long)i * G + c; if (L >= (long)nwg * rep) return false;
        int wgid = (int)(L % nwg); { const int q = nwg / NXCD, r = nwg % NXCD, xcd = wgid % NXCD, off = wgid / NXCD; wgid = (xcd < r ? xcd * (q + 1) : r * (q + 1) + (xcd - r) * q) + off; }
        const int nig = WGM * nN, gid = wgid / nig, fm = gid * WGM, gsz = (nM - fm) < WGM ? (nM - fm) : WGM;
        u.pm = fm + ((wgid % nig) % gsz); u.pn = (wgid % nig) / gsz; return true;
    }
    __device__ __forceinline__ void a_ready(const Unit&) const {}
    __device__ __forceinline__ void done(const Unit&) const {}
};

__device__ __forceinline__ unsigned cvt_pk_bf16(float lo, float hi) { unsigned r; asm("v_cvt_pk_bf16_f32 %0, %1, %2" : "=v"(r) : "v"(lo), "v"(hi)); return r; }
__device__ __forceinline__ f32x2 gelu_pk(f32x2 v) {
    const f32x2 av = __builtin_elementwise_abs(v), d = av * 0.2316418882f + 1.0f;
    f32x2 t; t.x = __builtin_amdgcn_rcpf(d.x); t.y = __builtin_amdgcn_rcpf(d.y);
    f32x2 q = t * 0.5307027145f + (-0.7265760135f); q = q * t + 0.7107068705f; q = q * t + (-0.142248368f); q = q * t + 0.127414796f; q = q * t;
    const f32x2 s = (v * v) * (-0.72134752044f);
    f32x2 e; e.x = __builtin_amdgcn_exp2f(s.x); e.y = __builtin_amdgcn_exp2f(s.y);
    const f32x2 m = v * (q * e), r = v - m;
    f32x2 o; o.x = v.x < 0.f ? m.x : r.x; o.y = v.y < 0.f ? m.y : r.y; return o;
}

struct EpiBf16G {
    static constexpr bool PERM = true, AFTER_DRAIN = false;
    bf16_t* O; int ldc; int gelu_tiles;
    __device__ __forceinline__ void operator()(const f32x4 (&acc)[2][2][4][2], const Unit& u, int wr, int wc, int fr, int fq) const {
        const int row0 = u.pm * BM + wr * 64 + fr; const int col0 = u.pn * BM + wc * 32 + 8 * fq;
        const bool g = u.pn < gelu_tiles;
#pragma unroll
        for (int ai = 0; ai < 2; ++ai)
#pragma unroll
            for (int m = 0; m < 4; ++m) { bf16_t* rowp = O + (size_t)(row0 + ai * HALF + m * 16) * ldc + col0;
#pragma unroll
                for (int bj = 0; bj < 2; ++bj) { f32x4 v0 = acc[ai][bj][m][0], v1 = acc[ai][bj][m][1];
                    if (g) { f32x2 a = gelu_pk((f32x2){v0[0], v0[1]}), b = gelu_pk((f32x2){v0[2], v0[3]}), c = gelu_pk((f32x2){v1[0], v1[1]}), d = gelu_pk((f32x2){v1[2], v1[3]});
                        v0 = (f32x4){a.x, a.y, b.x, b.y}; v1 = (f32x4){c.x, c.y, d.x, d.y}; }
                    u32x4 w; w.x = cvt_pk_bf16(v0[0], v0[1]); w.y = cvt_pk_bf16(v0[2], v0[3]); w.z = cvt_pk_bf16(v1[0], v1[1]); w.w = cvt_pk_bf16(v1[2], v1[3]);
                    *(u32x4*)(rowp + bj * HALF) = w; } }
    }
};
struct EpiRes {
    static constexpr bool PERM = false, AFTER_DRAIN = false;
    const float* x; float* out; const float* gate; int gstride;
    __device__ __forceinline__ void operator()(const f32x4 (&acc)[2][2][4][2], const Unit& u, int wr, int wc, int fr, int fq) const {
        const int row0 = u.pm * BM + wr * 64 + fr; const int col0 = u.pn * BM + wc * 32 + 4 * fq;
        const float* gp = gate + (size_t)(u.pm >> 3) * gstride + col0;
#pragma unroll
        for (int bj = 0; bj < 2; ++bj)
#pragma unroll
            for (int n = 0; n < 2; ++n) { const f32x4 g4 = *(const f32x4*)(gp + bj * HALF + n * 16);
#pragma unroll
                for (int ai = 0; ai < 2; ++ai)
#pragma unroll
                    for (int m = 0; m < 4; ++m) { const size_t off = (size_t)(row0 + ai * HALF + m * 16) * 2048 + col0 + bj * HALF + n * 16;
                        const f32x4 xv = *(const f32x4*)(x + off); *(f32x4*)(out + off) = xv + g4 * acc[ai][bj][m][n]; }
                asm volatile("" ::: "memory"); }
    }
};

template <class Epi, class Sched, bool ALIGN_EPI = false, bool SP2 = false>
__device__ __forceinline__ void gemm_phase(PG8_LAS unsigned char* lds, const Gemm g, const Sched& S, const Epi& E) {
    const int tid = threadIdx.x, wid = __builtin_amdgcn_readfirstlane(tid >> 6), lane = tid & 63, wr = wid >> 2, wc = wid & 3, fr = lane & 15, fq = lane >> 4;
    const int K = g.K, nt = K / BK;
    unsigned voffA[2], voffB[2];
#pragma unroll
    for (int i = 0; i < 2; ++i) { int R, C; stage_rc(tid * 16 + i * 8192, R, C); const int Rb = Epi::PERM ? ((R & ~31) + perm32(R & 31)) : R;
        voffA[i] = (unsigned)(R * K + C) * 2u; voffB[i] = (unsigned)(Rb * K + C) * 2u; }
    const size_t kstep = (size_t)(BK * 2);
    const size_t hstep = (size_t)HALF * K * 2;
    const size_t tstep = 2 * hstep;
    const unsigned ldsw = (unsigned)wid * 1024u;
    const int aoff = lds_byte(wr * 64 + fr, fq * 8), boff = lds_byte(wc * 32 + fr, fq * 8);
#define PG8_SA(b, h) (((b) * 2 + (h)) * HTB)
#define PG8_SB(b, h) ((4 + (b) * 2 + (h)) * HTB)
#define PG8_STAGE(bufoff, gbase, voff) do { _Pragma("unroll") for (int _i = 0; _i < 2; ++_i) \
        __builtin_amdgcn_global_load_lds((const unsigned*)((const char*)(gbase) + (voff)[_i]), (PG8_LAS unsigned*)(lds + (bufoff) + ldsw + _i * 8192), 16, 0, 0); } while (0)
#define PG8_LDA(dst, b, h) do { _Pragma("unroll") for (int m = 0; m < 4; ++m) _Pragma("unroll") for (int k = 0; k < 2; ++k) dst[m][k] = *(const PG8_LAS bf16x8*)(lds + PG8_SA(b, h) + aoff + m * 2048 + k * 1024); } while (0)
#define PG8_LDB(dst, b, h) do { _Pragma("unroll") for (int n = 0; n < 2; ++n) _Pragma("unroll") for (int k = 0; k < 2; ++k) dst[n][k] = *(const PG8_LAS bf16x8*)(lds + PG8_SB(b, h) + boff + n * 2048 + k * 1024); } while (0)
#define PG8_MMA(ai, bj, At, Bt) do { __builtin_amdgcn_s_setprio(1); _Pragma("unroll") for (int m = 0; m < 4; ++m) _Pragma("unroll") for (int n = 0; n < 2; ++n) _Pragma("unroll") for (int k = 0; k < 2; ++k) \
        acc[ai][bj][m][n] = __builtin_amdgcn_mfma_f32_16x16x32_bf16(Bt[n][k], At[m][k], acc[ai][bj][m][n], 0, 0, 0); __builtin_amdgcn_s_setprio(0); } while (0)
#define PG8_WAIT_V(n) asm volatile("s_waitcnt vmcnt(" #n ")" ::: "memory")
#define PG8_WAIT_L(n) asm volatile("s_waitcnt lgkmcnt(" #n ")" ::: "memory")
#define PG8_BAR __builtin_amdgcn_s_barrier()
#define PG8_SCHED __builtin_amdgcn_sched_barrier(0)
    Unit cur, nxt; int ui = 0;
    if (!S.next(0, cur)) return;
    f32x4 acc[2][2][4][2];
#pragma unroll
    for (int a = 0; a < 2; ++a)
#pragma unroll
        for (int b = 0; b < 2; ++b)
#pragma unroll
            for (int m = 0; m < 4; ++m)
#pragma unroll
                for (int n = 0; n < 2; ++n) acc[a][b][m][n] = (f32x4){0.f, 0.f, 0.f, 0.f};
    bf16x8 At[4][2], B0[2][2], B1[2][2];
    const char* cA = (const char*)g.A + (size_t)cur.pm * tstep; const char* cB = (const char*)g.Bt + (size_t)cur.pn * tstep;
    S.a_ready(cur);
    if constexpr (SP2) {
        PG8_STAGE(PG8_SB(0, 0), cB, voffB); PG8_STAGE(PG8_SB(0, 1), cB + hstep, voffB); PG8_STAGE(PG8_SA(0, 0), cA, voffA); PG8_STAGE(PG8_SA(0, 1), cA + hstep, voffA);
        if (wr == 1) PG8_BAR;
        PG8_WAIT_V(2); PG8_BAR;
        PG8_STAGE(PG8_SB(1, 0), cB + kstep, voffB); PG8_STAGE(PG8_SA(1, 0), cA + kstep, voffA); PG8_STAGE(PG8_SB(1, 1), cB + hstep + kstep, voffB);
        PG8_WAIT_V(6); PG8_BAR;
    } else {
        PG8_STAGE(PG8_SB(0, 0), cB, voffB); PG8_STAGE(PG8_SA(0, 0), cA, voffA); PG8_STAGE(PG8_SB(0, 1), cB + hstep, voffB); PG8_STAGE(PG8_SA(0, 1), cA + hstep, voffA);
        if (wr == 1) PG8_BAR;
        PG8_WAIT_V(4); PG8_BAR;
        PG8_STAGE(PG8_SB(1, 0), cB + kstep, voffB); PG8_STAGE(PG8_SA(1, 0), cA + kstep, voffA); PG8_STAGE(PG8_SB(1, 1), cB + hstep + kstep, voffB);
        PG8_WAIT_V(6); PG8_BAR;
    }
    for (;;) {
        const bool has_next = S.next(ui + 1, nxt);
        const char* nA = has_next ? (const char*)g.A + (size_t)nxt.pm * tstep : cA; const char* nB = has_next ? (const char*)g.Bt + (size_t)nxt.pn * tstep : cB;
        for (int t = 0; t < nt; t += 2) {
            const bool last = (t == nt - 2);
            const char* a1 = cA + (size_t)(t + 1) * kstep;
            const char* a2 = last ? nA : cA + (size_t)(t + 2) * kstep; const char* b2 = last ? nB : cB + (size_t)(t + 2) * kstep;
            const char* a3 = a2 + kstep; const char* b3 = b2 + kstep;
            if (last && has_next) S.a_ready(nxt);
            if constexpr (SP2) {
            PG8_LDB(B0, 0, 0); PG8_LDB(B1, 0, 1); PG8_SCHED; PG8_LDA(At, 0, 0); PG8_STAGE(PG8_SA(1, 1), a1 + hstep, voffA);
            PG8_WAIT_V(8); PG8_WAIT_L(0); PG8_BAR; PG8_MMA(0, 0, At, B0); PG8_MMA(0, 1, At, B1); PG8_BAR; PG8_SCHED;
            PG8_LDA(At, 0, 1); PG8_STAGE(PG8_SB(0, 0), b2, voffB); PG8_STAGE(PG8_SB(0, 1), b2 + hstep, voffB); PG8_STAGE(PG8_SA(0, 0), a2, voffA);
            PG8_WAIT_V(8); PG8_WAIT_L(0); PG8_BAR; PG8_MMA(1, 0, At, B0); PG8_MMA(1, 1, At, B1); PG8_BAR; PG8_SCHED;
            PG8_LDB(B0, 1, 0); PG8_LDB(B1, 1, 1); PG8_SCHED; PG8_LDA(At, 1, 0); PG8_STAGE(PG8_SA(0, 1), a2 + hstep, voffA);
            PG8_WAIT_V(8); PG8_WAIT_L(0); PG8_BAR; PG8_MMA(0, 0, At, B0); PG8_MMA(0, 1, At, B1); PG8_BAR; PG8_SCHED;
            PG8_LDA(At, 1, 1); PG8_STAGE(PG8_SB(1, 0), b3, voffB); PG8_STAGE(PG8_SB(1, 1), b3 + hstep, voffB); PG8_STAGE(PG8_SA(1, 0), a3, voffA);
            PG8_WAIT_V(8); PG8_WAIT_L(0); PG8_BAR; PG8_MMA(1, 0, At, B0); PG8_MMA(1, 1, At, B1); PG8_BAR; PG8_SCHED;
            } else {
            PG8_LDB(B0, 0, 0); PG8_SCHED; PG8_LDA(At, 0, 0); PG8_STAGE(PG8_SA(1, 1), a1 + hstep, voffA);
            PG8_WAIT_L(8); PG8_BAR; PG8_WAIT_L(0); PG8_MMA(0, 0, At, B0); PG8_BAR; PG8_SCHED;
            PG8_LDB(B1, 0, 1); PG8_STAGE(PG8_SB(0, 0), b2, voffB);
            PG8_BAR; PG8_WAIT_L(0); PG8_MMA(0, 1, At, B1); PG8_BAR;
            PG8_LDA(At, 0, 1); PG8_STAGE(PG8_SA(0, 0), a2, voffA);
            PG8_BAR; PG8_WAIT_L(0); PG8_MMA(1, 0, At, B0); PG8_BAR; PG8_SCHED;
            PG8_STAGE(PG8_SB(0, 1), b2 + hstep, voffB);
            PG8_WAIT_V(6); PG8_BAR; PG8_MMA(1, 1, At, B1); PG8_BAR;
            PG8_LDB(B0, 1, 0); PG8_SCHED; PG8_LDA(At, 1, 0); PG8_STAGE(PG8_SA(0, 1), a2 + hstep, voffA);
            PG8_WAIT_L(8); PG8_BAR; PG8_WAIT_L(0); PG8_MMA(0, 0, At, B0); PG8_BAR; PG8_SCHED;
            PG8_LDB(B1, 1, 1); PG8_STAGE(PG8_SB(1, 0), b3, voffB);
            PG8_BAR; PG8_WAIT_L(0); PG8_MMA(0, 1, At, B1); PG8_BAR;
            PG8_LDA(At, 1, 1); PG8_STAGE(PG8_SA(1, 0), a3, voffA);
            PG8_BAR; PG8_WAIT_L(0); PG8_MMA(1, 0, At, B0); PG8_BAR; PG8_SCHED;
            PG8_STAGE(PG8_SB(1, 1), b3 + hstep, voffB);
            PG8_WAIT_V(6); PG8_BAR; PG8_MMA(1, 1, At, B1); PG8_BAR;
            }
        }
        if constexpr (ALIGN_EPI) { if (wr == 0) PG8_BAR; }
        if constexpr (!Epi::AFTER_DRAIN) { E(acc, cur, wr, wc, fr, fq); S.done(cur); }
        if (!has_next) break;
#pragma unroll
        for (int a = 0; a < 2; ++a)
#pragma unroll
            for (int b = 0; b < 2; ++b)
#pragma unroll
                for (int m = 0; m < 4; ++m)
#pragma unroll
                    for (int n = 0; n < 2; ++n) acc[a][b][m][n] = (f32x4){0.f, 0.f, 0.f, 0.f};
        cur = nxt; cA = nA; cB = nB; ++ui;
        if constexpr (ALIGN_EPI) { if (wr == 1) PG8_BAR; }
    }
    PG8_WAIT_V(0);
    if constexpr (!ALIGN_EPI) { if (wr == 0) PG8_BAR; }
    PG8_BAR;
#undef PG8_SA
#undef PG8_SB
#undef PG8_STAGE
#undef PG8_LDA
#undef PG8_LDB
#undef PG8_MMA
#undef PG8_WAIT_V
#undef PG8_WAIT_L
#undef PG8_BAR
#undef PG8_SCHED
}
}

typedef unsigned short bf16;
typedef float f32x4 __attribute__((ext_vector_type(4)));
typedef float f32x2 __attribute__((ext_vector_type(2)));
typedef float f32x16 __attribute__((ext_vector_type(16)));
typedef short bf16x8 __attribute__((ext_vector_type(8)));
typedef unsigned u32x4 __attribute__((ext_vector_type(4)));
typedef unsigned u32x2 __attribute__((ext_vector_type(2)));
typedef __bf16 bf16v2 __attribute__((ext_vector_type(2)));

constexpr int NW = 8, NT = 512;
constexpr int MTOK = 16384, SEQ = 2048, DM = 2048, NIN = 5408, NINP = 5632, NMODC = 12288;
constexpr size_t MiB = 1u << 20;
constexpr size_t WS_MOD = 1 * MiB, WS_KEYS = 2 * MiB, WS_W2T = WS_KEYS + 512 * 1024, WS_A2T = WS_W2T + 128 * 1024, WS_G2T = WS_A2T + 128 * 1024;
constexpr size_t WS_WIN = 4 * MiB, WS_WOUT = 26 * MiB, WS_WQ = 34 * MiB, WS_PU = 42 * MiB, WS_PV = 106 * MiB, WS_HB = 170 * MiB, WS_P = 234 * MiB;
constexpr size_t WS_KP = 410 * MiB, WS_KK = 442 * MiB, WS_BB = 474 * MiB, WS_VV = 506 * MiB, WS_END = 538 * MiB;
constexpr size_t WS_Y = WS_P, WS_Q = WS_P + 64 * MiB, WS_EIDX = WS_P + 128 * MiB, WS_GATE = WS_P + 136 * MiB;
constexpr size_t OUT_DEC = 0, OUT_G = 64 * MiB, OUT_R = 96 * MiB;
constexpr int LDS_BYTES = 147456;
constexpr int XB_LDS_OFF = 147456 - 64;
constexpr size_t CTL_ZERO_BYTES = 16384;
constexpr int NPHASE = 11;

struct Args { const float* in[29]; float* out; unsigned char* ws; int ph_lo, ph_hi; };

__device__ __forceinline__ float bf_lo(unsigned u) { return __uint_as_float(u << 16); }
__device__ __forceinline__ float bf_hi(unsigned u) { return __uint_as_float(u & 0xffff0000u); }
__device__ __forceinline__ float bf1(bf16 h) { return __uint_as_float((unsigned)h << 16); }
__device__ __forceinline__ unsigned pk2(float lo, float hi) { return pg8::cvt_pk_bf16(lo, hi); }
__device__ __forceinline__ bf16 f2bf(float f) { return (bf16)(pg8::cvt_pk_bf16(f, 0.f) & 0xffffu); }
template <int CTRL> __device__ __forceinline__ float dpp_mov(float v) { return __int_as_float(__builtin_amdgcn_update_dpp(0, __float_as_int(v), CTRL, 0xF, 0xF, true)); }
__device__ __forceinline__ float quad_sum(float v) { v += dpp_mov<0xB1>(v); v += dpp_mov<0x4E>(v); return v; }
__device__ __forceinline__ float row16_sum(float v) { v = quad_sum(v); v += dpp_mov<0x141>(v); v += dpp_mov<0x140>(v); return v; }
__device__ __forceinline__ float half32_sum(float v) { v = row16_sum(v); v += __shfl_xor(v, 16); return v; }
__device__ __forceinline__ float wave_sum(float v) { v = row16_sum(v); v += __shfl_xor(v, 16); v += __shfl_xor(v, 32); return v; }
__device__ __forceinline__ int kmax(int a, int b) { int r; asm("v_max_f32 %0, %1, %2" : "=v"(r) : "v"(a), "v"(b)); return r; }
__device__ __forceinline__ int kmin(int a, int b) { int r; asm("v_min_f32 %0, %1, %2" : "=v"(r) : "v"(a), "v"(b)); return r; }
__device__ __forceinline__ int kmed3(int a, int b, int c) { int r; asm("v_med3_f32 %0, %1, %2, %3" : "=v"(r) : "v"(a), "v"(b), "v"(c)); return r; }
__device__ __forceinline__ float gelu1(float x) { return 0.5f * x * (1.0f + erff(x * 0.70710678118654752f)); }
__device__ __forceinline__ float sigmoid1(float x) { return __builtin_amdgcn_rcpf(1.0f + __expf(-x)); }
__device__ __forceinline__ float tanh_fast(float x) { const float e = __expf(-2.0f * fabsf(x)); const float t = (1.0f - e) * __builtin_amdgcn_rcpf(1.0f + e); return x < 0.f ? -t : t; }

__device__ __forceinline__ void p0_transpose_item(const float* W, int K, int N, bf16* WT, float* scr, int item, int lane) {
    const int nblk = N / 32, kb = item / nblk, nb = item % nblk, k0 = 64 * kb, n0 = 32 * nb;
#pragma unroll 8
    for (int i = 0; i < 32; ++i) { const int kk = 2 * i + (lane >> 5); scr[kk * 33 + (lane & 31)] = W[(size_t)(k0 + kk) * N + n0 + (lane & 31)]; }
    asm volatile("s_waitcnt lgkmcnt(0)" ::: "memory");
    const int c = lane & 7;
#pragma unroll
    for (int j = 0; j < 4; ++j) { const int n = (lane >> 3) + 8 * j; const float* s = scr + (8 * c) * 33 + n;
        u32x4 o; o.x = pk2(s[0 * 33], s[1 * 33]); o.y = pk2(s[2 * 33], s[3 * 33]); o.z = pk2(s[4 * 33], s[5 * 33]); o.w = pk2(s[6 * 33], s[7 * 33]);
        *(u32x4*)(WT + (size_t)(n0 + n) * K + k0 + 8 * c) = o; }
    asm volatile("s_waitcnt lgkmcnt(0)" ::: "memory");
}

__device__ __forceinline__ void norm_mod_rows(const float* X, const float* g, const float* mod, int shi, int sci, bf16* H, int gw, int NGW, int lane, int rep = 1) {
    for (int t_ = gw; t_ < MTOK * rep; t_ += NGW) { const int t = t_ & (MTOK - 1);
        const int b = t >> 11;
        const f32x4* xr = (const f32x4*)(X + (size_t)t * DM) + lane;
        f32x4 v[8]; float ss = 0.f;
#pragma unroll
        for (int j = 0; j < 8; ++j) { v[j] = xr[64 * j]; ss += (v[j].x * v[j].x + v[j].y * v[j].y) + (v[j].z * v[j].z + v[j].w * v[j].w); }
        ss = wave_sum(ss);
        const float rinv = rsqrtf(ss * (1.0f / DM) + 1e-6f);
        const float* mb = mod + (size_t)b * NMODC;
#pragma unroll
        for (int j = 0; j < 8; ++j) { const int col = 4 * lane + 256 * j;
            const f32x4 g4 = *(const f32x4*)(g + col), sc4 = *(const f32x4*)(mb + sci * DM + col), sh4 = *(const f32x4*)(mb + shi * DM + col);
            const f32x4 o = (v[j] * rinv) * g4 * (sc4 + 1.0f) + sh4;
            u32x2 w; w.x = pk2(o.x, o.y); w.y = pk2(o.z, o.w);
            *(u32x2*)(H + (size_t)t * DM + col) = w; }
    }
}


#define LAS __attribute__((address_space(3)))
#define XB_TMO      128
#define XB_XCNT(j)  (256  + 64 * (j))
#define XB_XSUB(j)  (1280 + 64 * (j))
#define XB_XGEN(j)  (2304 + 64 * (j))
#define XB_TOP      3328
#define XB_TOPGEN   3392
#define XCD_BAR_WORDS 3456
#define XB_SPIN_CAP (1u << 18)

__device__ __forceinline__ unsigned xb_ld(unsigned* p)              { return __hip_atomic_load(p, __ATOMIC_RELAXED, __HIP_MEMORY_SCOPE_AGENT); }
__device__ __forceinline__ unsigned xb_add(unsigned* p, unsigned v) { return __hip_atomic_fetch_add(p, v, __ATOMIC_RELAXED, __HIP_MEMORY_SCOPE_AGENT); }
__device__ __forceinline__ unsigned xb_xcc_id() { return (unsigned)__builtin_amdgcn_s_getreg((3 << 11) | 20) & 0xFu; }
#define XB_SPIN(cond, bar) do { unsigned _sp = 0; while (cond) { __builtin_amdgcn_s_sleep(1); \
    if ((++_sp & 255u) == 0u) { if (xb_ld(&(bar)[XB_TMO])) break; if (_sp > XB_SPIN_CAP) { atomicAdd(&(bar)[XB_TMO], 1u); break; } } } } while (0)

struct XcdBarrier {
    unsigned* bar; unsigned x;
    volatile LAS unsigned* st;
};

__device__ __forceinline__ XcdBarrier xcd_barrier_post(unsigned* bar, volatile LAS unsigned* st) {
    XcdBarrier b; b.bar = bar; b.x = xb_xcc_id(); b.st = st;
    if (threadIdx.x == 0) (void)xb_add(&bar[XB_XCNT(b.x)], 1u);
    return b;
}
__device__ __forceinline__ void xcd_barrier_complete(unsigned* bar, unsigned x, unsigned& nloc, unsigned& nx) {
    const unsigned G = gridDim.x * gridDim.y * gridDim.z;
    unsigned sum, cnt, mine, sp = 0u;
    for (;;) {
        sum = 0u; cnt = 0u; mine = 0u;
#pragma unroll
        for (unsigned j = 0; j < 16; ++j) { const unsigned c = xb_ld(&bar[XB_XCNT(j)]); sum += c; cnt += (c > 0u) ? 1u : 0u; mine = (j == x) ? c : mine; }
        if (sum == G) break;
        __builtin_amdgcn_s_sleep(1);
        if ((++sp & 255u) == 0u) { if (xb_ld(&bar[XB_TMO])) break; if (sp > XB_SPIN_CAP) { atomicAdd(&bar[XB_TMO], 1u); break; } }
    }
    nloc = mine > 0u ? mine : 1u; nx = cnt > 0u ? cnt : 1u;
}

__device__ __forceinline__ void xcd_barrier(const XcdBarrier& b) {
    asm volatile("s_waitcnt vmcnt(0)" ::: "memory");
    __syncthreads();
    if (threadIdx.x == 0) {
        unsigned* bar = b.bar;
        __builtin_amdgcn_s_waitcnt(0);
        unsigned nloc = b.st[0], nx = b.st[1];
        if (nloc == 0u) { xcd_barrier_complete(bar, b.x, nloc, nx); b.st[0] = nloc; b.st[1] = nx; }
        const unsigned old = xb_add(&bar[XB_XSUB(b.x)], 1u);
        const unsigned gen = old / nloc;
        if (old + 1u == (gen + 1u) * nloc) {
            __builtin_amdgcn_fence(__ATOMIC_RELEASE, "agent");
            asm volatile("s_waitcnt vmcnt(0)" ::: "memory");
            const unsigned og = xb_add(&bar[XB_TOP], 1u);
            const unsigned tg = og / nx;
            if (og + 1u == (tg + 1u) * nx) xb_add(&bar[XB_TOPGEN], 1u);
            else XB_SPIN(xb_ld(&bar[XB_TOPGEN]) == tg, bar);
            __builtin_amdgcn_fence(__ATOMIC_ACQUIRE, "agent");
            xb_add(&bar[XB_XGEN(b.x)], 1u);
            asm volatile("s_waitcnt vmcnt(0)" ::: "memory");
        } else {
            XB_SPIN(xb_ld(&bar[XB_XGEN(b.x)]) == gen, bar);
            __builtin_amdgcn_fence(__ATOMIC_ACQUIRE, "agent");
            asm volatile("s_waitcnt vmcnt(0)" ::: "memory");
        }
    }
    __syncthreads();
}


#define CONVERT_EXPERT_ROWS(R0, R1, WID, NWV) do { \
    for (int r = (R0) + (WID); r < (R1); r += (NWV)) { \
        const int row = r & 16383; \
        const float* srcp = args.in[26] + (size_t)row * DM; \
        f32x4 v[8]; float am = 0.f; \
        _Pragma("unroll") for (int j = 0; j < 2; ++j) _Pragma("unroll") for (int q = 0; q < 4; ++q) { const f32x4 t = *(const f32x4*)(srcp + j * 1024 + lane * 16 + q * 4); v[j * 4 + q] = t; \
            am = fmaxf(am, fmaxf(fmaxf(fabsf(t.x), fabsf(t.y)), fmaxf(fabsf(t.z), fabsf(t.w)))); } \
        _Pragma("unroll") for (int o = 1; o < 64; o <<= 1) am = fmaxf(am, __shfl_xor(am, o)); \
        const float sc = am > 0.f ? 240.0f / am : 1.0f, inv = am > 0.f ? am * (1.0f / 240.0f) : 1.0f; \
        unsigned char* dst = PU8 + (size_t)row * DM; \
        _Pragma("unroll") for (int j = 0; j < 2; ++j) { u32x4 o; \
            _Pragma("unroll") for (int q = 0; q < 4; ++q) { const f32x4 t = v[j * 4 + q] * sc; int p = __builtin_amdgcn_cvt_pk_fp8_f32(t.x, t.y, 0, false); p = __builtin_amdgcn_cvt_pk_fp8_f32(t.z, t.w, p, true); o[q] = (unsigned)p; } \
            *(u32x4*)(dst + j * 1024 + lane * 16) = o; } \
        if (lane == 0) SCL[r] = inv; \
    } } while (0)
#define CONVERT_EXPERT_FP4_ROWS(SRC, DST, SCLP, WID, NWV) do { \
    for (int row = (WID); row < 16384; row += (NWV)) { \
        const float* srcp = (SRC) + (size_t)row * DM + lane * 32; \
        f32x4 v[8]; float am = 0.f, ss = 0.f; \
        _Pragma("unroll") for (int q = 0; q < 8; ++q) { const f32x4 t = *(const f32x4*)(srcp + q * 4); v[q] = t; \
            am = fmaxf(am, fmaxf(fmaxf(fabsf(t.x), fabsf(t.y)), fmaxf(fabsf(t.z), fabsf(t.w)))); ss += (t.x * t.x + t.y * t.y) + (t.z * t.z + t.w * t.w); } \
        _Pragma("unroll") for (int o = 1; o < 64; o <<= 1) am = fmaxf(am, __shfl_xor(am, o)); \
        ss = wave_sum(ss); \
        float unit = fmaxf(sqrtf(ss * (1.0f / DM)) * 0.5f, am * (1.0f / 9.0f)); if (!(unit > 0.f)) unit = 1.0f; \
        const float sc = 1.0f / unit; u32x4 o; \
        _Pragma("unroll") for (int d = 0; d < 4; ++d) { const f32x4 t0 = v[2 * d] * sc, t1 = v[2 * d + 1] * sc; unsigned p = 0u; \
            p = __builtin_amdgcn_cvt_scalef32_pk_fp4_f32(p, t0.x, t0.y, 1.0f, 0); p = __builtin_amdgcn_cvt_scalef32_pk_fp4_f32(p, t0.z, t0.w, 1.0f, 1); \
            p = __builtin_amdgcn_cvt_scalef32_pk_fp4_f32(p, t1.x, t1.y, 1.0f, 2); p = __builtin_amdgcn_cvt_scalef32_pk_fp4_f32(p, t1.z, t1.w, 1.0f, 3); o[d] = p; } \
        *(u32x4*)((DST) + (size_t)row * 1024 + lane * 16) = o; \
        if (lane == 0) (SCLP)[row] = unit; \
    } } while (0)

__global__ void __launch_bounds__(NT, 2) mk_fwd(Args args) {
    extern __shared__ __attribute__((aligned(16))) unsigned char lds[];
    const int tid = threadIdx.x, lane = tid & 63, wave = __builtin_amdgcn_readfirstlane(tid >> 6);
    const int G = gridDim.x, bx = blockIdx.x;
    const int gw = bx * NW + wave, NGW = G * NW;
    const int gtid = bx * NT + tid, NGT = G * NT;
    unsigned char* ws = args.ws;
    const int lo = args.ph_lo, hi = args.ph_hi;
    volatile LAS unsigned* xst = (volatile LAS unsigned*)((LAS unsigned char*)lds + XB_LDS_OFF);
    if (tid < 4) xst[tid] = 0u;
    __syncthreads();
    XcdBarrier xbar = xcd_barrier_post((unsigned*)ws, xst);
    if (args.ph_lo == -7777) cg::this_grid().sync();
#ifndef P3SEL
#define P3SEL(x) (x)
#endif
#ifndef PH_MASK
#define PH_MASK 0x7ff
#endif
#define IN(k) (((PH_MASK >> (k)) & 1) && lo <= (k) && (k) < hi)
#ifndef PROBE_REP
#define PROBE_REP -1
#endif
#define REPS(k)
#define RMUL(k) ((k) == PROBE_REP ? 2 : 1)
#define SEAM(k) do { if (IN(k) && IN((k) + 1)) xcd_barrier(xbar); } while (0)

    const float* x = args.in[0];
    float* MOD = (float*)(ws + WS_MOD);
    bf16* KEYSB = (bf16*)(ws + WS_KEYS); bf16* W2T = (bf16*)(ws + WS_W2T); bf16* A2T = (bf16*)(ws + WS_A2T); bf16* G2T = (bf16*)(ws + WS_G2T);
    bf16* WIN = (bf16*)(ws + WS_WIN); bf16* WOUT = (bf16*)(ws + WS_WOUT); bf16* WQ = (bf16*)(ws + WS_WQ);
    unsigned char* PU8 = ws + WS_PU; unsigned char* PV8 = ws + WS_PU + 32 * MiB; float* SCL = (float*)(ws + WS_PV); bf16* HB = (bf16*)(ws + WS_HB); bf16* P = (bf16*)(ws + WS_P);
    bf16* KP = (bf16*)(ws + WS_KP); bf16* KKn = (bf16*)(ws + WS_KK); bf16* BB = (bf16*)(ws + WS_BB); bf16* VV = (bf16*)(ws + WS_VV);
    float* Y = (float*)(ws + WS_Y); bf16* Q = (bf16*)(ws + WS_Q); int* EIDX = (int*)(ws + WS_EIDX); float* GATE = (float*)(ws + WS_GATE);
    float* DEC = (float*)((unsigned char*)args.out + OUT_DEC); bf16* GG = (bf16*)((unsigned char*)args.out + OUT_G); bf16* RR = (bf16*)((unsigned char*)args.out + OUT_R);

    if (IN(0)) REPS(0) {
        if (bx < 192) {
            const float* c = args.in[1]; const float* ada_w = args.in[2]; const float* ada_b = args.in[3];
            float* sct = (float*)lds;
            for (int i = tid; i < 8 * 2048; i += NT) { const int b = i >> 11, k = i & 2047; const float cv = c[i]; sct[k * 8 + b] = cv / (1.0f + __expf(-cv)); }
            __syncthreads();
            const int n0 = bx * 64, rg = lane >> 4, cl = lane & 15;
            f32x4 acc[8];
#pragma unroll
            for (int b = 0; b < 8; ++b) acc[b] = (f32x4){0.f, 0.f, 0.f, 0.f};
            const float* wp = ada_w + (size_t)(wave * 256 + rg) * NMODC + n0 + cl * 4;
#pragma unroll 4
            for (int i = 0; i < 64; ++i) {
                const f32x4 w = *(const f32x4*)(wp + (size_t)i * 4 * NMODC);
                const int k = wave * 256 + i * 4 + rg;
                const f32x4 s0 = *(const f32x4*)(sct + k * 8), s1 = *(const f32x4*)(sct + k * 8 + 4);
                acc[0] += w * s0.x; acc[1] += w * s0.y; acc[2] += w * s0.z; acc[3] += w * s0.w;
                acc[4] += w * s1.x; acc[5] += w * s1.y; acc[6] += w * s1.z; acc[7] += w * s1.w;
            }
            float* red = (float*)(lds + 65536);
#pragma unroll
            for (int b = 0; b < 8; ++b) {
#pragma unroll
                for (int q = 0; q < 4; ++q) { float v = acc[b][q]; v += __shfl_xor(v, 16); v += __shfl_xor(v, 32); acc[b][q] = v; }
                if (rg == 0) *(f32x4*)(red + (wave * 8 + b) * 64 + cl * 4) = acc[b];
            }
            __syncthreads();
            { const int b = tid >> 6, col = tid & 63; float s = ada_b[n0 + col];
#pragma unroll
              for (int w = 0; w < 8; ++w) s += red[(w * 8 + b) * 64 + col];
              MOD[(size_t)b * NMODC + n0 + col] = s; }
            __syncthreads();
        }
        {
            float* scr = (float*)(lds + wave * 16384);
            constexpr int I_IN = (DM / 64) * (NIN / 32), I_SQ = (DM / 64) * (DM / 32);
            for (int it = gw; it < I_IN + 2 * I_SQ; it += NGW) {
                int r = it;
                if (r < I_IN) { p0_transpose_item(args.in[5], DM, NIN, WIN, scr, r, lane); continue; } r -= I_IN;
                if (r < I_SQ) { p0_transpose_item(args.in[22], DM, DM, WOUT, scr, r, lane); continue; } r -= I_SQ;
                p0_transpose_item(args.in[24], DM, DM, WQ, scr, r, lane);
            }
        }
        {
            u32x4* z = (u32x4*)(WIN + (size_t)NIN * DM);
            for (int i = gtid; i < (NINP - NIN) * DM / 8; i += NGT) z[i] = (u32x4){0u, 0u, 0u, 0u};
            const float* w2 = args.in[13]; const float* a2 = args.in[15]; const float* g2 = args.in[16]; const float* keys = args.in[25];
            for (int i = gtid; i < 1024 * 64; i += NGT) { const int n = i >> 6, k = i & 63; W2T[i] = f2bf(w2[k * 1024 + n]); A2T[i] = f2bf(a2[k * 1024 + n]); }
            for (int i = gtid; i < 1024 * 160; i += NGT) { const int n = i / 160, k = i % 160; G2T[i] = f2bf(g2[k * 1024 + n]); }
            for (int i = gtid; i < 262144 / 2; i += NGT) { const f32x2 v = *(const f32x2*)(keys + 2 * i); ((unsigned*)KEYSB)[i] = pk2(v.x, v.y); }
        }
    }
    SEAM(0);

    if (IN(1)) norm_mod_rows(x, args.in[4], MOD, 0, 1, HB, gw, NGW, lane, RMUL(1));
    SEAM(1);

    if (IN(2)) {
        pg8::Gemm g{HB, WIN, MTOK, NINP, DM}; pg8::StaticOrder S; S.init(MTOK, NINP, G, bx, RMUL(2));
        pg8::EpiBf16G E{P, NINP, 8};
        pg8::gemm_phase<pg8::EpiBf16G, pg8::StaticOrder, true, true>((PG8_LAS unsigned char*)lds, g, S, E);
        if (G == 256) { if (bx >= 128) CONVERT_EXPERT_FP4_ROWS(args.in[26], PU8, SCL, (bx - 128) * NW + wave, 128 * NW); }
        else CONVERT_EXPERT_FP4_ROWS(args.in[26], PU8, SCL, gw, NGW);
    }
    SEAM(2);

    if (IN(3)) REPS(3) {
        for (int item_ = bx; item_ < 256 * RMUL(3); item_ += G) {
            const int item = item_ & 255;
            __syncthreads();
            {
                const int t0 = item * 64;
                bf16* Al = (bf16*)lds;
                bf16* Ks = (bf16*)(lds + 40960);
                const float* mu = args.in[11];
                {
                    const int tl = tid >> 3, cb = (tid & 7) * 36; const int t = t0 + tl; const bool first = (t & (SEQ - 1)) == 0;
                    const bf16* cur = P + (size_t)t * NINP + 2048 + 3072 + cb; const bf16* prv = cur - NINP;
#pragma unroll 6
                    for (int q = 0; q < 18; ++q) { const unsigned c2 = *(const unsigned*)(cur + 2 * q); const unsigned p2 = first ? 0u : *(const unsigned*)(prv + 2 * q);
                        const int c = cb + 2 * q; const float m0 = mu[3072 + c], m1 = mu[3072 + c + 1];
                        float v0 = bf_lo(c2), v1 = bf_hi(c2); v0 += (bf_lo(p2) - v0) * m0; v1 += (bf_hi(p2) - v1) * m1;
                        if (c < 64) { v0 = tanh_fast(v0); v1 = tanh_fast(v1); } else if (c >= 128) { v0 = sigmoid1(v0); v1 = sigmoid1(v1); }
                        *(unsigned*)(Al + tl * 296 + c) = pk2(v0, v1); }
                }
                const int c0 = wave * 128;
                const float* w0p = args.in[12]; const float* a0p = args.in[14]; const float* kkw = args.in[17]; const float* kaw = args.in[18];
#define RW_ZERO() do { _Pragma("unroll") for (int b_ = 0; b_ < 4; ++b_) _Pragma("unroll") for (int r_ = 0; r_ < 16; ++r_) acc[b_][r_] = 0.f; } while (0)
#define RW_MM(BT, KB, ACOL, NKS) do { _Pragma("unroll 2") for (int ks = 0; ks < (NKS); ++ks) { bf16x8 bfr[4]; \
        const bf16x8 af = *(const bf16x8*)(Al + (mt * 32 + (lane & 31)) * 296 + (ACOL) + ks * 16 + (lane >> 5) * 8); \
        _Pragma("unroll") for (int b_ = 0; b_ < 4; ++b_) bfr[b_] = *(const bf16x8*)((BT) + (size_t)(c0 + b_ * 32 + (lane & 31)) * (KB) + ks * 16 + (lane >> 5) * 8); \
        _Pragma("unroll") for (int b_ = 0; b_ < 4; ++b_) acc[b_] = __builtin_amdgcn_mfma_f32_32x32x16_bf16(af, bfr[b_], acc[b_], 0, 0, 0); } } while (0)
#pragma unroll 1
                for (int mt = 0; mt < 2; ++mt) {
                    __syncthreads();
#pragma unroll 6
                    for (int op = tid; op < 3 * 32 * 128; op += NT) {
                        const int which = op >> 12, tl = (op >> 7) & 31, c8 = (op & 127) * 8; const int t = t0 + mt * 32 + tl; const bool first = (t & (SEQ - 1)) == 0;
                        const bf16* cp = P + (size_t)t * NINP + 2048 + which * 1024 + c8;
                        const u32x4 cu = *(const u32x4*)cp; u32x4 pr = (u32x4){0u, 0u, 0u, 0u}; if (!first) pr = *(const u32x4*)(cp - NINP);
                        const f32x4 m0 = *(const f32x4*)(mu + which * 1024 + c8), m1 = *(const f32x4*)(mu + which * 1024 + c8 + 4);
                        u32x4 o;
                        { float a = bf_lo(cu.x), b = bf_hi(cu.x); a += (bf_lo(pr.x) - a) * m0.x; b += (bf_hi(pr.x) - b) * m0.y; o.x = pk2(a, b); }
                        { float a = bf_lo(cu.y), b = bf_hi(cu.y); a += (bf_lo(pr.y) - a) * m0.z; b += (bf_hi(pr.y) - b) * m0.w; o.y = pk2(a, b); }
                        { float a = bf_lo(cu.z), b = bf_hi(cu.z); a += (bf_lo(pr.z) - a) * m1.x; b += (bf_hi(pr.z) - b) * m1.y; o.z = pk2(a, b); }
                        { float a = bf_lo(cu.w), b = bf_hi(cu.w); a += (bf_lo(pr.w) - a) * m1.z; b += (bf_hi(pr.w) - b) * m1.w; o.w = pk2(a, b); }
                        if (which == 0) *(u32x4*)(RR + (size_t)t * 1024 + c8) = o;
                        else if (which == 2) *(u32x4*)(VV + (size_t)t * 1024 + c8) = o;
                        else *(u32x4*)(Ks + tl * 1032 + c8) = o;
                    }
                    __syncthreads();
                    f32x16 acc[4];
                    RW_ZERO(); RW_MM(W2T, 64, 0, 4);
#pragma unroll
                    for (int nt = 0; nt < 4; ++nt) { const int col = c0 + nt * 32 + (lane & 31); const float w0v = w0p[col];
#pragma unroll
                        for (int r = 0; r < 16; ++r) { const int t = t0 + mt * 32 + (r & 3) + 8 * (r >> 2) + 4 * (lane >> 5);
                            const float sg = sigmoid1(w0v + acc[nt][r]);
                            DEC[(size_t)t * 1024 + col] = __expf(-0.60653065971f * sg); }
                        asm volatile("" ::: "memory"); }
                    RW_ZERO(); RW_MM(A2T, 64, 64, 4);
#pragma unroll
                    for (int hh = 0; hh < 2; ++hh) {
                        const int colA = c0 + hh * 64 + (lane & 31), colB = colA + 32;
                        const float a0A = a0p[colA], a0B = a0p[colB], kkA = kkw[colA], kkB = kkw[colB], kaA = kaw[colA], kaB = kaw[colB];
#pragma unroll
                        for (int r = 0; r < 16; ++r) { const int tl = (r & 3) + 8 * (r >> 2) + 4 * (lane >> 5); const int t = t0 + mt * 32 + tl;
                            const float kA = bf1(Ks[tl * 1032 + colA]), kB = bf1(Ks[tl * 1032 + colB]);
                            const float aA = sigmoid1(a0A + acc[hh * 2][r]), aB = sigmoid1(a0B + acc[hh * 2 + 1][r]);
                            const float qA = kA * kkA, qB = kB * kkB;
                            const float ss = half32_sum(qA * qA + qB * qB);
                            const float inv = __builtin_amdgcn_rsqf(fmaxf(ss, 1e-24f));
                            const float nA = qA * inv, nB = qB * inv;
                            const size_t oA = (size_t)t * 1024 + colA, oB = oA + 32;
                            KP[oA] = f2bf(kA * (1.0f + (aA - 1.0f) * kaA)); KP[oB] = f2bf(kB * (1.0f + (aB - 1.0f) * kaB));
                            KKn[oA] = f2bf(nA); KKn[oB] = f2bf(nB); BB[oA] = f2bf(nA * aA); BB[oB] = f2bf(nB * aB);
                            if ((r & 3) == 3) asm volatile("" ::: "memory"); }
                    }
                    RW_ZERO(); RW_MM(G2T, 160, 128, 10);
#pragma unroll
                    for (int nt = 0; nt < 4; ++nt) { const int col = c0 + nt * 32 + (lane & 31);
#pragma unroll
                        for (int r = 0; r < 16; ++r) { const int t = t0 + mt * 32 + (r & 3) + 8 * (r >> 2) + 4 * (lane >> 5);
                            GG[(size_t)t * 1024 + col] = f2bf(acc[nt][r]); }
                        asm volatile("" ::: "memory"); }
                }
            }
        }
#undef RW_ZERO
#undef RW_MM
        for (int item_ = bx; item_ < 256 * RMUL(3); item_ += G) {
            const int item = item_ & 255;
            __syncthreads();
            {
                const int T0 = (item >> 1) * 128, hg = (item & 1) * 4;
                bf16* VnT = (bf16*)lds;
                f32x2* st = (f32x2*)(lds + 36864);
                const float* vg = args.in[6]; const float* vb = args.in[7]; const float* wsp = args.in[8]; const float* bs = args.in[9];
#pragma unroll 1
                for (int i0 = 0; i0 < 16; i0 += 4) {
                    u32x4 a[4], b[4];
#pragma unroll
                    for (int i = 0; i < 4; ++i) { const bf16* row = P + (size_t)(T0 + wave * 16 + i0 + i) * NINP + 1024; a[i] = *(const u32x4*)(row + lane * 8); b[i] = *(const u32x4*)(row + 512 + lane * 8); }
#pragma unroll
                    for (int i = 0; i < 4; ++i) { float s = 0.f, s2 = 0.f;
#pragma unroll
                        for (int q = 0; q < 4; ++q) { const float v0 = bf_lo(a[i][q]), v1 = bf_hi(a[i][q]), v2 = bf_lo(b[i][q]), v3 = bf_hi(b[i][q]); s += (v0 + v1) + (v2 + v3); s2 += (v0 * v0 + v1 * v1) + (v2 * v2 + v3 * v3); }
                        s = wave_sum(s); s2 = wave_sum(s2);
                        const float mean = s * (1.0f / 1024.0f); const float var = fmaxf(s2 * (1.0f / 1024.0f) - mean * mean, 0.f);
                        if (lane == 0) st[wave * 16 + i0 + i] = (f32x2){mean, rsqrtf(var + 1e-5f)}; }
                }
                for (int hh = 0; hh < 4; ++hh) {
                    const int h = hg + hh;
                    __syncthreads();
                    {
                        const int j = tid >> 2, d0 = (tid & 3) * 32; const f32x2 sj = st[j];
                        const bf16* src = P + (size_t)(T0 + j) * NINP + 1024 + h * 128 + d0;
                        u32x4 a[4];
#pragma unroll
                        for (int q = 0; q < 4; ++q) a[q] = *(const u32x4*)(src + q * 8);
#pragma unroll
                        for (int q = 0; q < 4; ++q) {
#pragma unroll
                            for (int e = 0; e < 4; ++e) { const int d = d0 + q * 8 + e * 2; const int col = h * 128 + d;
                                const float v0 = (bf_lo(a[q][e]) - sj.x) * sj.y * vg[col] + vb[col], v1 = (bf_hi(a[q][e]) - sj.x) * sj.y * vg[col + 1] + vb[col + 1];
                                VnT[d * 136 + j] = f2bf(v0); VnT[(d + 1) * 136 + j] = f2bf(v1); } }
                    }
                    __syncthreads();
                    const int it_ = wave >> 1, dt0 = (wave & 1) * 2, nks = (it_ < 2) ? 4 : 8;
                    bf16 gu[2][16];
#pragma unroll
                    for (int q = 0; q < 2; ++q)
#pragma unroll
                        for (int r = 0; r < 16; ++r) { const int i = it_ * 32 + (r & 3) + 8 * (r >> 2) + 4 * (lane >> 5), d = (dt0 + q) * 32 + (lane & 31);
                            gu[q][r] = P[(size_t)(T0 + i) * NINP + h * 128 + d]; }
                    f32x16 acc[2];
#pragma unroll
                    for (int q = 0; q < 2; ++q)
#pragma unroll
                        for (int r = 0; r < 16; ++r) acc[q][r] = 0.f;
                    const float* wrow = wsp + ((size_t)h * 128 + it_ * 32 + (lane & 31)) * 128 + (lane >> 5) * 8;
#pragma unroll 2
                    for (int ks = 0; ks < nks; ++ks) {
                        const f32x4 w0 = *(const f32x4*)(wrow + ks * 16), w1 = *(const f32x4*)(wrow + ks * 16 + 4);
                        u32x4 au; au.x = pk2(w0.x, w0.y); au.y = pk2(w0.z, w0.w); au.z = pk2(w1.x, w1.y); au.w = pk2(w1.z, w1.w);
                        const bf16x8 af = __builtin_bit_cast(bf16x8, au);
#pragma unroll
                        for (int q = 0; q < 2; ++q) { const bf16x8 bfr = *(const bf16x8*)(VnT + ((dt0 + q) * 32 + (lane & 31)) * 136 + ks * 16 + (lane >> 5) * 8);
                            acc[q] = __builtin_amdgcn_mfma_f32_32x32x16_bf16(af, bfr, acc[q], 0, 0, 0); }
                    }
#pragma unroll
                    for (int q = 0; q < 2; ++q)
#pragma unroll
                        for (int r = 0; r < 16; ++r) { const int i = it_ * 32 + (r & 3) + 8 * (r >> 2) + 4 * (lane >> 5), d = (dt0 + q) * 32 + (lane & 31);
                            const float z = acc[q][r] + bs[h * 128 + i];
                            HB[(size_t)(T0 + i) * DM + h * 128 + d] = f2bf(bf1(gu[q][r]) * z); }
                }
            }
        }
    }
    SEAM(3);

    if (IN(4)) {
        constexpr int TC = 32, BUF = 45056;
        float* yp = (float*)(lds + BUF);
#define LDS_BARRIER() do { asm volatile("s_waitcnt lgkmcnt(0)" ::: "memory"); __builtin_amdgcn_s_barrier(); asm volatile("" ::: "memory"); } while (0)
        for (int task_ = bx; task_ < 256 * RMUL(4); task_ += G) {
            const int task = task_ & 255; const int bh = task >> 1, half = task & 1, b = bh >> 4, h = bh & 15;
            const int stp = tid >> 4, q = tid & 15;
            const size_t base = ((size_t)b * SEQ + stp) * 1024 + h * 64;
            f32x4 ld_dec; u32x2 ld_kk, ld_bb, ld_kp, ld_rr; unsigned ld_vv;
#define SC_LOAD(tc) do { const size_t o_ = base + (size_t)(tc) * 1024 + q * 4; ld_dec = *(const f32x4*)(DEC + o_); ld_kk = *(const u32x2*)(KKn + o_); ld_bb = *(const u32x2*)(BB + o_); \
            ld_kp = *(const u32x2*)(KP + o_); ld_rr = *(const u32x2*)(RR + o_); ld_vv = *(const unsigned*)(VV + base + (size_t)(tc) * 1024 + half * 32 + q * 2); } while (0)
#define SC_STORE() do { float* B_ = (float*)lds; const int o_ = stp * 64 + q * 4; *(f32x4*)(B_ + o_) = ld_dec; \
            *(f32x4*)(B_ + 2048 + o_) = (f32x4){-bf_lo(ld_kk.x), -bf_hi(ld_kk.x), -bf_lo(ld_kk.y), -bf_hi(ld_kk.y)}; \
            *(f32x4*)(B_ + 4096 + o_) = (f32x4){bf_lo(ld_bb.x), bf_hi(ld_bb.x), bf_lo(ld_bb.y), bf_hi(ld_bb.y)}; \
            *(f32x4*)(B_ + 6144 + o_) = (f32x4){bf_lo(ld_kp.x), bf_hi(ld_kp.x), bf_lo(ld_kp.y), bf_hi(ld_kp.y)}; \
            *(f32x4*)(B_ + 8192 + o_) = (f32x4){bf_lo(ld_rr.x), bf_hi(ld_rr.x), bf_lo(ld_rr.y), bf_hi(ld_rr.y)}; \
            *(f32x2*)(B_ + 10240 + stp * 32 + q * 2) = (f32x2){bf_lo(ld_vv), bf_hi(ld_vv)}; } while (0)
            __syncthreads();
            SC_LOAD(0); SC_STORE();
            __syncthreads();
            f32x4 S = (f32x4){0.f, 0.f, 0.f, 0.f};
            const int row = wave * 4 + (lane >> 4), kl = lane & 15;
            const float* B_ = (const float*)lds;
            for (int c = 0; c < SEQ / TC; ++c) {
                if (c + 1 < SEQ / TC) SC_LOAD((c + 1) * TC);
#define SC_LD(W, A, Bv, K, R, V, s_) do { const float* p_ = B_ + (s_) * 64 + kl * 4; W = *(const f32x4*)p_; A = *(const f32x4*)(p_ + 2048); Bv = *(const f32x4*)(p_ + 4096); K = *(const f32x4*)(p_ + 6144); R = *(const f32x4*)(p_ + 8192); V = B_[10240 + (s_) * 32 + row]; } while (0)
#define SC_STEP(W, A, Bv, K, R, V, s_) do { float sa_ = S.x * A.x; sa_ = fmaf(S.y, A.y, sa_); sa_ = fmaf(S.z, A.z, sa_); sa_ = fmaf(S.w, A.w, sa_); \
                    sa_ = row16_sum(sa_); S = S * W + Bv * sa_ + K * V; \
                    float y_ = S.x * R.x; y_ = fmaf(S.y, R.y, y_); y_ = fmaf(S.z, R.z, y_); y_ = fmaf(S.w, R.w, y_); yp[((s_) * 32 + row) * 16 + kl] = y_; } while (0)
                f32x4 w0, a0, b0, k0, r0, w1, a1, b1, k1, r1; float v0, v1;
                SC_LD(w0, a0, b0, k0, r0, v0, 0);
#pragma unroll
                for (int s = 0; s < TC; s += 2) {
                    SC_LD(w1, a1, b1, k1, r1, v1, s + 1);
                    SC_STEP(w0, a0, b0, k0, r0, v0, s);
                    if (s + 2 < TC) SC_LD(w0, a0, b0, k0, r0, v0, s + 2);
                    SC_STEP(w1, a1, b1, k1, r1, v1, s + 1);
                }
#undef SC_LD
#undef SC_STEP
                LDS_BARRIER();
#pragma unroll
                for (int o2 = 0; o2 < 2; ++o2) {
                    const int oi = tid + o2 * NT; const float* pp = yp + oi * 16; const f32x4 p0 = *(const f32x4*)pp, p1 = *(const f32x4*)(pp + 4), p2 = *(const f32x4*)(pp + 8), p3 = *(const f32x4*)(pp + 12);
                    const f32x4 t = (p0 + p1) + (p2 + p3);
                    Y[((size_t)b * SEQ + c * TC + (oi >> 5)) * 1024 + h * 64 + half * 32 + (oi & 31)] = (t.x + t.y) + (t.z + t.w); }
                if (c + 1 < SEQ / TC) SC_STORE();
                LDS_BARRIER();
            }
#undef SC_LOAD
#undef SC_STORE
        }
#undef LDS_BARRIER
    }
    SEAM(4);

    if (IN(5)) {
        const float* rk = args.in[19]; const float* lng = args.in[20]; const float* lnb = args.in[21]; const float* og = args.in[10];
        for (int t_ = gw; t_ < MTOK * RMUL(5); t_ += NGW) { const int t = t_ & (MTOK - 1);
            const size_t o = (size_t)t * 1024 + lane * 16;
            f32x4 y[4];
#pragma unroll
            for (int j = 0; j < 4; ++j) y[j] = *(const f32x4*)(Y + o + 4 * j);
            float s = 0.f;
#pragma unroll
            for (int j = 0; j < 4; ++j) s += (y[j].x + y[j].y) + (y[j].z + y[j].w);
            s = quad_sum(s); const float mean = s * (1.0f / 64.0f);
            float s2 = 0.f;
#pragma unroll
            for (int j = 0; j < 4; ++j) { y[j] = y[j] - mean; s2 += (y[j].x * y[j].x + y[j].y * y[j].y) + (y[j].z * y[j].z + y[j].w * y[j].w); }
            s2 = quad_sum(s2); const float rstd = rsqrtf(s2 * (1.0f / 64.0f) + 64e-5f);
            u32x4 r8[2], k8[2], v8[2], g8[2];
#pragma unroll
            for (int j = 0; j < 2; ++j) { r8[j] = *(const u32x4*)(RR + o + 8 * j); k8[j] = *(const u32x4*)(KP + o + 8 * j); v8[j] = *(const u32x4*)(VV + o + 8 * j); g8[j] = *(const u32x4*)(GG + o + 8 * j); }
            float dp = 0.f;
#pragma unroll
            for (int j = 0; j < 2; ++j)
#pragma unroll
                for (int e = 0; e < 4; ++e) { const int col = lane * 16 + j * 8 + e * 2; dp += bf_lo(r8[j][e]) * bf_lo(k8[j][e]) * rk[col] + bf_hi(r8[j][e]) * bf_hi(k8[j][e]) * rk[col + 1]; }
            dp = quad_sum(dp);
            u32x4 ov[2];
#pragma unroll
            for (int j = 0; j < 2; ++j)
#pragma unroll
                for (int e = 0; e < 4; ++e) { const int c = j * 8 + e * 2; const int col = lane * 16 + c;
                    const float y0 = y[c >> 2][c & 3], y1 = y[(c + 1) >> 2][(c + 1) & 3];
                    const float o0 = (y0 * rstd * lng[col] + lnb[col] + dp * bf_lo(v8[j][e])) * bf_lo(g8[j][e]);
                    const float o1 = (y1 * rstd * lng[col + 1] + lnb[col + 1] + dp * bf_hi(v8[j][e])) * bf_hi(g8[j][e]);
                    ov[j][e] = pk2(o0, o1); }
            bf16* op = HB + (size_t)t * DM + 1024 + lane * 16;
            *(u32x4*)op = ov[0]; *(u32x4*)(op + 8) = ov[1];
            {
                bf16* ap = HB + (size_t)t * DM + lane * 16; u32x4 ya[2]; ya[0] = *(const u32x4*)ap; ya[1] = *(const u32x4*)(ap + 8);
                float q2 = 0.f;
#pragma unroll
                for (int j = 0; j < 2; ++j)
#pragma unroll
                    for (int e = 0; e < 4; ++e) { const float v0 = bf_lo(ya[j][e]), v1 = bf_hi(ya[j][e]); q2 += v0 * v0 + v1 * v1; }
                q2 = wave_sum(q2);
                const float ri = rsqrtf(q2 * (1.0f / 1024.0f) + 1e-6f);
#pragma unroll
                for (int j = 0; j < 2; ++j)
#pragma unroll
                    for (int e = 0; e < 4; ++e) { const int col = lane * 16 + j * 8 + e * 2; ya[j][e] = pk2(bf_lo(ya[j][e]) * ri * og[col], bf_hi(ya[j][e]) * ri * og[col + 1]); }
                *(u32x4*)ap = ya[0]; *(u32x4*)(ap + 8) = ya[1];
            }
        }
    }
    SEAM(5);

    if (IN(6)) {
        pg8::Gemm g{HB, WOUT, MTOK, DM, DM}; pg8::StaticOrder S; S.init(MTOK, DM, G, bx, RMUL(6));
        pg8::EpiRes E{x, args.out, MOD + 2 * DM, NMODC};
        pg8::gemm_phase<pg8::EpiRes, pg8::StaticOrder, true, true>((PG8_LAS unsigned char*)lds, g, S, E);
    }
    SEAM(6);

    if (IN(7)) norm_mod_rows(args.out, args.in[23], MOD, 3, 4, HB, gw, NGW, lane);
    SEAM(7);

    if (IN(8)) {
        pg8::Gemm g{HB, WQ, MTOK, DM, DM}; pg8::StaticOrder S; S.init(MTOK, DM, G, bx);
        pg8::EpiBf16G E{Q, DM, 0};
        pg8::gemm_phase<pg8::EpiBf16G, pg8::StaticOrder, true, true>((PG8_LAS unsigned char*)lds, g, S, E);
    }
    SEAM(8);

    if (IN(9)) REPS(9) {
        float* scr = (float*)(lds + wave * 8704);
        for (int task_ = gw; task_ < (MTOK / 64) * 8 * RMUL(9); task_ += NGW) {
            const int task = task_ & 2047; const int tt = task >> 3, h = task & 7;
            int T0[16], T1[16];
#pragma unroll
            for (int p = 0; p < 2; ++p) {
                int T[16];
#pragma unroll
                for (int j = 0; j < 16; ++j) T[j] = (int)0xff7fffff;
                const bf16* qa = Q + (size_t)(tt * 64 + (lane & 31)) * DM + h * 256 + p * 128 + (lane >> 5) * 8;
                for (int nc = 0; nc < 4; ++nc) {
                    f32x16 acc[2];
#pragma unroll
                    for (int mt = 0; mt < 2; ++mt)
#pragma unroll
                        for (int r = 0; r < 16; ++r) acc[mt][r] = 0.f;
                    const bf16* kb = KEYSB + ((size_t)(h * 2 + p) * 128 + nc * 32 + (lane & 31)) * 128 + (lane >> 5) * 8;
#pragma unroll
                    for (int ks = 0; ks < 8; ++ks) { const bf16x8 bfr = *(const bf16x8*)(kb + ks * 16);
                        const bf16x8 af0 = *(const bf16x8*)(qa + ks * 16), af1 = *(const bf16x8*)(qa + (size_t)32 * DM + ks * 16);
                        acc[0] = __builtin_amdgcn_mfma_f32_32x32x16_bf16(af0, bfr, acc[0], 0, 0, 0);
                        acc[1] = __builtin_amdgcn_mfma_f32_32x32x16_bf16(af1, bfr, acc[1], 0, 0, 0); }
#pragma unroll
                    for (int mt = 0; mt < 2; ++mt)
#pragma unroll
                        for (int r = 0; r < 16; ++r) scr[(mt * 32 + (r & 3) + 8 * (r >> 2) + 4 * (lane >> 5)) * 33 + (lane & 31)] = acc[mt][r];
                    asm volatile("s_waitcnt lgkmcnt(0)" ::: "memory");
#pragma unroll 4
                    for (int j = 0; j < 32; ++j) {
                        int key = (__float_as_int(scr[lane * 33 + j]) & ~127) | (127 - (nc * 32 + j));
#pragma unroll
                        for (int u = 0; u < 16; u += 2) {
                            const int t0_ = T[u], t1_ = T[u + 1]; T[u] = kmax(t0_, key); T[u + 1] = kmed3(t0_, t1_, key); key = kmin(t1_, key); }
                    }
                    asm volatile("s_waitcnt lgkmcnt(0)" ::: "memory");
                }
#pragma unroll
                for (int j = 0; j < 16; ++j) { if (p == 0) T0[j] = T[j]; else T1[j] = T[j]; }
            }
            float tv[16]; int te[16];
#pragma unroll
            for (int j = 0; j < 16; ++j) { tv[j] = -3.0e38f; te[j] = 0; }
#pragma unroll
            for (int i = 0; i < 16; ++i)
#pragma unroll
                for (int j = 0; j < 16; ++j) if ((i + 1) * (j + 1) <= 16) {
                    const int m0 = T0[i] & ~127, m1 = T1[j] & ~127;
                    const float s0 = __int_as_float(m0), s1 = __int_as_float(m1);
                    float fv = s0 + s1; int pe = ((127 - (T0[i] & 127)) << 7) | (127 - (T1[j] & 127));
#pragma unroll
                    for (int u = 0; u < 16; ++u) { const bool c = fv > tv[u]; const float nv = c ? fv : tv[u]; const int ne = c ? pe : te[u]; fv = c ? tv[u] : fv; pe = c ? te[u] : pe; tv[u] = nv; te[u] = ne; }
                }
            {
                const float mx = tv[0]; float sum = 0.f;
#pragma unroll
                for (int j = 0; j < 16; ++j) { tv[j] = __expf(tv[j] - mx); sum += tv[j]; }
                const float inv = 1.0f / sum;
#pragma unroll
                for (int j = 0; j < 16; ++j) tv[j] *= inv;
            }
            const size_t o = (size_t)(tt * 64 + lane) * 128 + h * 16;
#pragma unroll
            for (int j = 0; j < 16; ++j) { EIDX[o + j] = te[j]; GATE[o + j] = tv[j]; }
        }
        CONVERT_EXPERT_FP4_ROWS(args.in[27], PV8, SCL + 16384, gw, NGW);
    }
    SEAM(9);

    if (IN(10)) {
        const float* fg = args.in[28];
        for (int tok = gw; tok < MTOK; tok += NGW) {
            const int b = tok >> 11;
            f32x2 hf2[16];
#pragma unroll
            for (int j = 0; j < 4; ++j) { const u32x4 a = *(const u32x4*)(HB + (size_t)tok * DM + lane * 32 + j * 8);
#pragma unroll
                for (int q = 0; q < 4; ++q) hf2[j * 4 + q] = (f32x2){bf_lo(a[q]), bf_hi(a[q])}; }
            const int e0 = EIDX[(size_t)tok * 128 + lane], e1 = EIDX[(size_t)tok * 128 + 64 + lane];
            const float g0 = GATE[(size_t)tok * 128 + lane], g1 = GATE[(size_t)tok * 128 + 64 + lane];
            const bool hi32 = (lane & 32) != 0, hi16 = (lane & 16) != 0; const int l3 = (lane & 3) << 4;
#define PU_LOAD(BUF, EV, S0) do { _Pragma("unroll") for (int i = 0; i < 8; ++i) { const int row_ = __builtin_amdgcn_readlane(EV, (S0) + i); BUF[i & 3][i >> 2] = *(const u32x4*)(PU8 + (size_t)row_ * 1024 + lane * 16); } } while (0)
#define PU_DOT4(BUF, H, S0) do { float d_[4]; _Pragma("unroll") for (int i = 0; i < 4; ++i) { f32x2 da_ = (f32x2){0.f, 0.f}; \
        _Pragma("unroll") for (int q = 0; q < 4; ++q) { const unsigned w_ = BUF[i][H][q]; \
            da_ = __builtin_elementwise_fma(__builtin_amdgcn_cvt_scalef32_pk_f32_fp4(w_, 1.0f, 0), hf2[q * 4 + 0], da_); da_ = __builtin_elementwise_fma(__builtin_amdgcn_cvt_scalef32_pk_f32_fp4(w_, 1.0f, 1), hf2[q * 4 + 1], da_); \
            da_ = __builtin_elementwise_fma(__builtin_amdgcn_cvt_scalef32_pk_f32_fp4(w_, 1.0f, 2), hf2[q * 4 + 2], da_); da_ = __builtin_elementwise_fma(__builtin_amdgcn_cvt_scalef32_pk_f32_fp4(w_, 1.0f, 3), hf2[q * 4 + 3], da_); } d_[i] = da_.x + da_.y; } \
        float k0_ = hi32 ? d_[2] : d_[0], k1_ = hi32 ? d_[3] : d_[1]; const float s0_ = hi32 ? d_[0] : d_[2], s1_ = hi32 ? d_[1] : d_[3]; \
        k0_ += __shfl_xor(s0_, 32); k1_ += __shfl_xor(s1_, 32); float k_ = hi16 ? k1_ : k0_; const float s_ = hi16 ? k0_ : k1_; k_ += __shfl_xor(s_, 16); k_ = row16_sum(k_); \
        const float t_ = __shfl(k_, l3); if ((lane >> 2) == ((S0) >> 2)) dv = t_; } while (0)
            float act0 = 0.f, act1 = 0.f;
            u32x4 bA[4][2], bB[4][2];
#pragma unroll
            for (int hh = 0; hh < 2; ++hh) {
                const int ev = hh ? e1 : e0; const float gv = hh ? g1 : g0; float dv = 0.f;
                PU_LOAD(bA, ev, 0);
#pragma unroll 1
                for (int s = 0; s < 64; s += 16) {
                    PU_LOAD(bB, ev, s + 8);
                    PU_DOT4(bA, 0, s); PU_DOT4(bA, 1, s + 4);
                    if (s + 16 < 64) PU_LOAD(bA, ev, s + 16);
                    PU_DOT4(bB, 0, s + 8); PU_DOT4(bB, 1, s + 12);
                }
                const float d = dv * SCL[ev];
                const float a = gelu1(d) * gv * SCL[16384 + ev];
                if (hh) act1 = a; else act0 = a;
            }
#undef PU_LOAD
#undef PU_DOT4
            f32x2 acc2[16];
#pragma unroll
            for (int i = 0; i < 16; ++i) acc2[i] = (f32x2){0.f, 0.f};
#define PV_LOAD(BUF, EV, S0) do { _Pragma("unroll") for (int i = 0; i < 8; ++i) { const int row_ = __builtin_amdgcn_readlane(EV, (S0) + i); BUF[i & 3][i >> 2] = *(const u32x4*)(PV8 + (size_t)row_ * 1024 + lane * 16); } } while (0)
#define PV_ACC(BUF, AV, S0) do { _Pragma("unroll") for (int i = 0; i < 8; ++i) { const float a_ = __int_as_float(__builtin_amdgcn_readlane(__float_as_int(AV), (S0) + i)); const f32x2 a2_ = (f32x2){a_, a_}; \
        _Pragma("unroll") for (int q = 0; q < 4; ++q) { const unsigned w_ = BUF[i & 3][i >> 2][q]; \
            acc2[q * 4 + 0] = __builtin_elementwise_fma(a2_, __builtin_amdgcn_cvt_scalef32_pk_f32_fp4(w_, 1.0f, 0), acc2[q * 4 + 0]); acc2[q * 4 + 1] = __builtin_elementwise_fma(a2_, __builtin_amdgcn_cvt_scalef32_pk_f32_fp4(w_, 1.0f, 1), acc2[q * 4 + 1]); \
            acc2[q * 4 + 2] = __builtin_elementwise_fma(a2_, __builtin_amdgcn_cvt_scalef32_pk_f32_fp4(w_, 1.0f, 2), acc2[q * 4 + 2]); acc2[q * 4 + 3] = __builtin_elementwise_fma(a2_, __builtin_amdgcn_cvt_scalef32_pk_f32_fp4(w_, 1.0f, 3), acc2[q * 4 + 3]); } } } while (0)
#pragma unroll
            for (int hh = 0; hh < 2; ++hh) {
                const int ev = hh ? e1 : e0; const float av = hh ? act1 : act0;
                PV_LOAD(bA, ev, 0);
#pragma unroll 1
                for (int s = 0; s < 64; s += 16) {
                    PV_LOAD(bB, ev, s + 8);
                    PV_ACC(bA, av, s);
                    if (s + 16 < 64) PV_LOAD(bA, ev, s + 16);
                    PV_ACC(bB, av, s + 8);
                }
            }
#undef PV_LOAD
#undef PV_ACC
            float acc[32];
#pragma unroll
            for (int i = 0; i < 16; ++i) { acc[2 * i] = acc2[i].x; acc[2 * i + 1] = acc2[i].y; }
            float* xr = args.out + (size_t)tok * DM + lane * 32; const float* gt2 = MOD + (size_t)b * NMODC + 5 * DM + lane * 32;
            float ss = 0.f;
#pragma unroll
            for (int q = 0; q < 8; ++q) { const f32x4 xv = *(const f32x4*)(xr + q * 4), g4 = *(const f32x4*)(gt2 + q * 4);
                float* a = acc + q * 4;
                a[0] = xv.x + g4.x * a[0]; a[1] = xv.y + g4.y * a[1]; a[2] = xv.z + g4.z * a[2]; a[3] = xv.w + g4.w * a[3];
                ss += (a[0] * a[0] + a[1] * a[1]) + (a[2] * a[2] + a[3] * a[3]); }
            ss = wave_sum(ss);
            const float rinv = rsqrtf(ss * (1.0f / DM) + 1e-6f);
#pragma unroll
            for (int q = 0; q < 8; ++q) { const f32x4 f4 = *(const f32x4*)(fg + lane * 32 + q * 4); const float* a = acc + q * 4;
                *(f32x4*)(xr + q * 4) = (f32x4){a[0] * rinv * f4.x, a[1] * rinv * f4.y, a[2] * rinv * f4.z, a[3] * rinv * f4.w}; }
        }
    }
#undef IN
#undef SEAM
}

extern "C" void kernel_launch(void* const* d_in, const int* in_sizes, int n_in, void* d_out, int out_size, void* d_ws, size_t ws_size, hipStream_t stream) {
    static int grid = 0;
    if (grid == 0) {
        if (n_in != 29 || ws_size < WS_END) { fprintf(stderr, "kernel_launch: unexpected n_in %d / ws %zu\n", n_in, ws_size); grid = -1; return; }
        int dev = 0, cus = 0, per_cu = 0;
        hipGetDevice(&dev); hipDeviceGetAttribute(&cus, hipDeviceAttributeMultiprocessorCount, dev);
        hipFuncSetAttribute((const void*)mk_fwd, hipFuncAttributeMaxDynamicSharedMemorySize, LDS_BYTES);
        hipOccupancyMaxActiveBlocksPerMultiprocessor(&per_cu, (const void*)mk_fwd, NT, LDS_BYTES);
        if (per_cu < 1) { fprintf(stderr, "kernel_launch: occupancy query says %d\n", per_cu); per_cu = 1; }
        if (per_cu > 1) per_cu = 1;
        grid = cus * per_cu;
        (void)hipGetLastError();
    }
    if (grid < 0) return;
    Args a{};
    for (int i = 0; i < 29; ++i) a.in[i] = (const float*)d_in[i];
    a.out = (float*)d_out; a.ws = (unsigned char*)d_ws;
#if MK_ONE_LAUNCH
    (void)hipMemsetAsync(d_ws, 0, CTL_ZERO_BYTES, stream);
    a.ph_lo = 0; a.ph_hi = NPHASE;
    void* kargs[] = {&a};
    hipError_t e = hipLaunchCooperativeKernel((const void*)mk_fwd, dim3(grid), dim3(NT), kargs, LDS_BYTES, stream);
    if (e != hipSuccess) fprintf(stderr, "cooperative launch failed: %s (grid %d)\n", hipGetErrorString(e), grid);
#else
    for (int p = 0; p < NPHASE; ++p) { a.ph_lo = p; a.ph_hi = p + 1; hipLaunchKernelGGL(mk_fwd, dim3(grid), dim3(NT), LDS_BYTES, stream, a); }
#endif
}
```

```cpp
#include <hip/hip_runtime.h>
#include <hip/hip_cooperative_groups.h>
#include <cstdio>
#include <cstdint>
namespace cg = cooperative_groups;

#ifndef MK_ONE_LAUNCH
#define MK_ONE_LAUNCH 1
#endif

namespace pg8 {
#define PG8_LAS __attribute__((address_space(3)))
typedef unsigned short bf16_t;
typedef short bf16x8 __attribute__((ext_vector_type(8)));
typedef float f32x4 __attribute__((ext_vector_type(4)));
typedef float f32x2 __attribute__((ext_vector_type(2)));
typedef unsigned u32x4 __attribute__((ext_vector_type(4)));
constexpr int BM = 256, BK = 64, HALF = 128, HTB = HALF * BK * 2, STAGE_BYTES = 8 * HTB, NXCD = 8, WGM = 8;

__host__ __device__ __forceinline__ int lds_byte(int r, int c) { const int st = (r >> 4) * 2 + (c >> 5), rr = r & 15, cc = c & 31, ob = rr * 64 + cc * 2; return st * 1024 + (ob ^ (((ob >> 9) & 1) << 5)); }
__host__ __device__ __forceinline__ void stage_rc(int b, int& R, int& C) { const int st = b / 1024, sb = b % 1024, swz = sb ^ (((sb >> 9) & 1) << 5); R = (st >> 1) * 16 + swz / 64; C = (st & 1) * 32 + (swz % 64) / 2; }
__host__ __device__ __forceinline__ int perm32(int rho) { const int n = rho >> 4, i = rho & 15; return 8 * (i >> 2) + 4 * n + (i & 3); }

struct Unit { int pm, pn; };
struct Gemm { const bf16_t* A; const bf16_t* Bt; int M, N, K; };

struct StaticOrder {
    int nM, nN, nwg, G, c, rep;
    __host__ __device__ void init(int M, int N, int G_, int c_, int rep_ = 1) { nM = M / BM; nN = N / BM; nwg = nM * nN; G = G_; c = c_; rep = rep_; }
    __host__ __device__ bool next(int i, Unit& u) const {
        const long L = (long)i * G + c; if (L >= (long)nwg * rep) return false;
        int wgid = (int)(L % nwg); { const int q = nwg / NXCD, r = nwg % NXCD, xcd = wgid % NXCD, off = wgid / NXCD; wgid = (xcd < r ? xcd * (q + 1) : r * (q + 1) + (xcd - r) * q) + off; }
        const int nig = WGM * nN, gid = wgid / nig, fm = gid * WGM, gsz = (nM - fm) < WGM ? (nM - fm) : WGM;
        u.pm = fm + ((wgid % nig) % gsz); u.pn = (wgid % nig) / gsz; return true;
    }
    __device__ __forceinline__ void a_ready(const Unit&) const {}
    __device__ __forceinline__ void done(const Unit&) const {}
};

__device__ __forceinline__ unsigned cvt_pk_bf16(float lo, float hi) { unsigned r; asm("v_cvt_pk_bf16_f32 %0, %1, %2" : "=v"(r) : "v"(lo), "v"(hi)); return r; }
__device__ __forceinline__ f32x2 gelu_pk(f32x2 v) {
    const f32x2 av = __builtin_elementwise_abs(v), d = av * 0.2316418882f + 1.0f;
    f32x2 t; t.x = __builtin_amdgcn_rcpf(d.x); t.y = __builtin_amdgcn_rcpf(d.y);
    f32x2 q = t * 0.5307027145f + (-0.7265760135f); q = q * t + 0.7107068705f; q = q * t + (-0.142248368f); q = q * t + 0.127414796f; q = q * t;
    const f32x2 s = (v * v) * (-0.72134752044f);
    f32x2 e; e.x = __builtin_amdgcn_exp2f(s.x); e.y = __builtin_amdgcn_exp2f(s.y);
    const f32x2 m = v * (q * e), r = v - m;
    f32x2 o; o.x = v.x < 0.f ? m.x : r.x; o.y = v.y < 0.f ? m.y : r.y; return o;
}

struct EpiBf16G {
    static constexpr bool PERM = true, AFTER_DRAIN = false;
    bf16_t* O; int ldc; int gelu_tiles;
    __device__ __forceinline__ void operator()(const f32x4 (&acc)[2][2][4][2], const Unit& u, int wr, int wc, int fr, int fq) const {
        const int row0 = u.pm * BM + wr * 64 + fr; const int col0 = u.pn * BM + wc * 32 + 8 * fq;
        const bool g = u.pn < gelu_tiles;
#pragma unroll
        for (int ai = 0; ai < 2; ++ai)
#pragma unroll
            for (int m = 0; m < 4; ++m) { bf16_t* rowp = O + (size_t)(row0 + ai * HALF + m * 16) * ldc + col0;
#pragma unroll
                for (int bj = 0; bj < 2; ++bj) { f32x4 v0 = acc[ai][bj][m][0], v1 = acc[ai][bj][m][1];
                    if (g) { f32x2 a = gelu_pk((f32x2){v0[0], v0[1]}), b = gelu_pk((f32x2){v0[2], v0[3]}), c = gelu_pk((f32x2){v1[0], v1[1]}), d = gelu_pk((f32x2){v1[2], v1[3]});
                        v0 = (f32x4){a.x, a.y, b.x, b.y}; v1 = (f32x4){c.x, c.y, d.x, d.y}; }
                    u32x4 w; w.x = cvt_pk_bf16(v0[0], v0[1]); w.y = cvt_pk_bf16(v0[2], v0[3]); w.z = cvt_pk_bf16(v1[0], v1[1]); w.w = cvt_pk_bf16(v1[2], v1[3]);
                    *(u32x4*)(rowp + bj * HALF) = w; } }
    }
};
struct EpiRes {
    static constexpr bool PERM = false, AFTER_DRAIN = false;
    const float* x; float* out; const float* gate; int gstride;
    __device__ __forceinline__ void operator()(const f32x4 (&acc)[2][2][4][2], const Unit& u, int wr, int wc, int fr, int fq) const {
        const int row0 = u.pm * BM + wr * 64 + fr; const int col0 = u.pn * BM + wc * 32 + 4 * fq;
        const float* gp = gate + (size_t)(u.pm >> 3) * gstride + col0;
#pragma unroll
        for (int bj = 0; bj < 2; ++bj)
#pragma unroll
            for (int n = 0; n < 2; ++n) { const f32x4 g4 = *(const f32x4*)(gp + bj * HALF + n * 16);
#pragma unroll
                for (int ai = 0; ai < 2; ++ai)
#pragma unroll
                    for (int m = 0; m < 4; ++m) { const size_t off = (size_t)(row0 + ai * HALF + m * 16) * 2048 + col0 + bj * HALF + n * 16;
                        const f32x4 xv = *(const f32x4*)(x + off); *(f32x4*)(out + off) = xv + g4 * acc[ai][bj][m][n]; }
                asm volatile("" ::: "memory"); }
    }
};

template <class Epi, class Sched, bool ALIGN_EPI = false, bool SP2 = false>
__device__ __forceinline__ void gemm_phase(PG8_LAS unsigned char* lds, const Gemm g, const Sched& S, const Epi& E) {
    const int tid = threadIdx.x, wid = __builtin_amdgcn_readfirstlane(tid >> 6), lane = tid & 63, wr = wid >> 2, wc = wid & 3, fr = lane & 15, fq = lane >> 4;
    const int K = g.K, nt = K / BK;
    unsigned voffA[2], voffB[2];
#pragma unroll
    for (int i = 0; i < 2; ++i) { int R, C; stage_rc(tid * 16 + i * 8192, R, C); const int Rb = Epi::PERM ? ((R & ~31) + perm32(R & 31)) : R;
        voffA[i] = (unsigned)(R * K + C) * 2u; voffB[i] = (unsigned)(Rb * K + C) * 2u; }
    const size_t kstep = (size_t)(BK * 2);
    const size_t hstep = (size_t)HALF * K * 2;
    const size_t tstep = 2 * hstep;
    const unsigned ldsw = (unsigned)wid * 1024u;
    const int aoff = lds_byte(wr * 64 + fr, fq * 8), boff = lds_byte(wc * 32 + fr, fq * 8);
#define PG8_SA(b, h) (((b) * 2 + (h)) * HTB)
#define PG8_SB(b, h) ((4 + (b) * 2 + (h)) * HTB)
#define PG8_STAGE(bufoff, gbase, voff) do { _Pragma("unroll") for (int _i = 0; _i < 2; ++_i) \
        __builtin_amdgcn_global_load_lds((const unsigned*)((const char*)(gbase) + (voff)[_i]), (PG8_LAS unsigned*)(lds + (bufoff) + ldsw + _i * 8192), 16, 0, 0); } while (0)
#define PG8_LDA(dst, b, h) do { _Pragma("unroll") for (int m = 0; m < 4; ++m) _Pragma("unroll") for (int k = 0; k < 2; ++k) dst[m][k] = *(const PG8_LAS bf16x8*)(lds + PG8_SA(b, h) + aoff + m * 2048 + k * 1024); } while (0)
#define PG8_LDB(dst, b, h) do { _Pragma("unroll") for (int n = 0; n < 2; ++n) _Pragma("unroll") for (int k = 0; k < 2; ++k) dst[n][k] = *(const PG8_LAS bf16x8*)(lds + PG8_SB(b, h) + boff + n * 2048 + k * 1024); } while (0)
#define PG8_MMA(ai, bj, At, Bt) do { __builtin_amdgcn_s_setprio(1); _Pragma("unroll") for (int m = 0; m < 4; ++m) _Pragma("unroll") for (int n = 0; n < 2; ++n) _Pragma("unroll") for (int k = 0; k < 2; ++k) \
        acc[ai][bj][m][n] = __builtin_amdgcn_mfma_f32_16x16x32_bf16(Bt[n][k], At[m][k], acc[ai][bj][m][n], 0, 0, 0); __builtin_amdgcn_s_setprio(0); } while (0)
#define PG8_WAIT_V(n) asm volatile("s_waitcnt vmcnt(" #n ")" ::: "memory")
#define PG8_WAIT_L(n) asm volatile("s_waitcnt lgkmcnt(" #n ")" ::: "memory")
#define PG8_BAR __builtin_amdgcn_s_barrier()
#define PG8_SCHED __builtin_amdgcn_sched_barrier(0)
    Unit cur, nxt; int ui = 0;
    if (!S.next(0, cur)) return;
    f32x4 acc[2][2][4][2];
#pragma unroll
    for (int a = 0; a < 2; ++a)
#pragma unroll
        for (int b = 0; b < 2; ++b)
#pragma unroll
            for (int m = 0; m < 4; ++m)
#pragma unroll
                for (int n = 0; n < 2; ++n) acc[a][b][m][n] = (f32x4){0.f, 0.f, 0.f, 0.f};
    bf16x8 At[4][2], B0[2][2], B1[2][2];
    const char* cA = (const char*)g.A + (size_t)cur.pm * tstep; const char* cB = (const char*)g.Bt + (size_t)cur.pn * tstep;
    S.a_ready(cur);
    if constexpr (SP2) {
        PG8_STAGE(PG8_SB(0, 0), cB, voffB); PG8_STAGE(PG8_SB(0, 1), cB + hstep, voffB); PG8_STAGE(PG8_SA(0, 0), cA, voffA); PG8_STAGE(PG8_SA(0, 1), cA + hstep, voffA);
        if (wr == 1) PG8_BAR;
        PG8_WAIT_V(2); PG8_BAR;
        PG8_STAGE(PG8_SB(1, 0), cB + kstep, voffB); PG8_STAGE(PG8_SA(1, 0), cA + kstep, voffA); PG8_STAGE(PG8_SB(1, 1), cB + hstep + kstep, voffB);
        PG8_WAIT_V(6); PG8_BAR;
    } else {
        PG8_STAGE(PG8_SB(0, 0), cB, voffB); PG8_STAGE(PG8_SA(0, 0), cA, voffA); PG8_STAGE(PG8_SB(0, 1), cB + hstep, voffB); PG8_STAGE(PG8_SA(0, 1), cA + hstep, voffA);
        if (wr == 1) PG8_BAR;
        PG8_WAIT_V(4); PG8_BAR;
        PG8_STAGE(PG8_SB(1, 0), cB + kstep, voffB); PG8_STAGE(PG8_SA(1, 0), cA + kstep, voffA); PG8_STAGE(PG8_SB(1, 1), cB + hstep + kstep, voffB);
        PG8_WAIT_V(6); PG8_BAR;
    }
    for (;;) {
        const bool has_next = S.next(ui + 1, nxt);
        const char* nA = has_next ? (const char*)g.A + (size_t)nxt.pm * tstep : cA; const char* nB = has_next ? (const char*)g.Bt + (size_t)nxt.pn * tstep : cB;
        for (int t = 0; t < nt; t += 2) {
            const bool last = (t == nt - 2);
            const char* a1 = cA + (size_t)(t + 1) * kstep;
            const char* a2 = last ? nA : cA + (size_t)(t + 2) * kstep; const char* b2 = last ? nB : cB + (size_t)(t + 2) * kstep;
            const char* a3 = a2 + kstep; const char* b3 = b2 + kstep;
            if (last && has_next) S.a_ready(nxt);
            if constexpr (SP2) {
            PG8_LDB(B0, 0, 0); PG8_LDB(B1, 0, 1); PG8_SCHED; PG8_LDA(At, 0, 0); PG8_STAGE(PG8_SA(1, 1), a1 + hstep, voffA);
            PG8_WAIT_V(8); PG8_WAIT_L(0); PG8_BAR; PG8_MMA(0, 0, At, B0); PG8_MMA(0, 1, At, B1); PG8_BAR; PG8_SCHED;
            PG8_LDA(At, 0, 1); PG8_STAGE(PG8_SB(0, 0), b2, voffB); PG8_STAGE(PG8_SB(0, 1), b2 + hstep, voffB); PG8_STAGE(PG8_SA(0, 0), a2, voffA);
            PG8_WAIT_V(8); PG8_WAIT_L(0); PG8_BAR; PG8_MMA(1, 0, At, B0); PG8_MMA(1, 1, At, B1); PG8_BAR; PG8_SCHED;
            PG8_LDB(B0, 1, 0); PG8_LDB(B1, 1, 1); PG8_SCHED; PG8_LDA(At, 1, 0); PG8_STAGE(PG8_SA(0, 1), a2 + hstep, voffA);
            PG8_WAIT_V(8); PG8_WAIT_L(0); PG8_BAR; PG8_MMA(0, 0, At, B0); PG8_MMA(0, 1, At, B1); PG8_BAR; PG8_SCHED;
            PG8_LDA(At, 1, 1); PG8_STAGE(PG8_SB(1, 0), b3, voffB); PG8_STAGE(PG8_SB(1, 1), b3 + hstep, voffB); PG8_STAGE(PG8_SA(1, 0), a3, voffA);
            PG8_WAIT_V(8); PG8_WAIT_L(0); PG8_BAR; PG8_MMA(1, 0, At, B0); PG8_MMA(1, 1, At, B1); PG8_BAR; PG8_SCHED;
            } else {
            PG8_LDB(B0, 0, 0); PG8_SCHED; PG8_LDA(At, 0, 0); PG8_STAGE(PG8_SA(1, 1), a1 + hstep, voffA);
            PG8_WAIT_L(8); PG8_BAR; PG8_WAIT_L(0); PG8_MMA(0, 0, At, B0); PG8_BAR; PG8_SCHED;
            PG8_LDB(B1, 0, 1); PG8_STAGE(PG8_SB(0, 0), b2, voffB);
            PG8_BAR; PG8_WAIT_L(0); PG8_MMA(0, 1, At, B1); PG8_BAR;
            PG8_LDA(At, 0, 1); PG8_STAGE(PG8_SA(0, 0), a2, voffA);
            PG8_BAR; PG8_WAIT_L(0); PG8_MMA(1, 0, At, B0); PG8_BAR; PG8_SCHED;
            PG8_STAGE(PG8_SB(0, 1), b2 + hstep, voffB);
            PG8_WAIT_V(6); PG8_BAR; PG8_MMA(1, 1, At, B1); PG8_BAR;
            PG8_LDB(B0, 1, 0); PG8_SCHED; PG8_LDA(At, 1, 0); PG8_STAGE(PG8_SA(0, 1), a2 + hstep, voffA);
            PG8_WAIT_L(8); PG8_BAR; PG8_WAIT_L(0); PG8_MMA(0, 0, At, B0); PG8_BAR; PG8_SCHED;
            PG8_LDB(B1, 1, 1); PG8_STAGE(PG8_SB(1, 0), b3, voffB);
            PG8_BAR; PG8_WAIT_L(0); PG8_MMA(0, 1, At, B1); PG8_BAR;
            PG8_LDA(At, 1, 1); PG8_STAGE(PG8_SA(1, 0), a3, voffA);
            PG8_BAR; PG8_WAIT_L(0); PG8_MMA(1, 0, At, B0); PG8_BAR; PG8_SCHED;
            PG8_STAGE(PG8_SB(1, 1), b3 + hstep, voffB);
            PG8_WAIT_V(6); PG8_BAR; PG8_MMA(1, 1, At, B1); PG8_BAR;
            }
        }
        if constexpr (ALIGN_EPI) { if (wr == 0) PG8_BAR; }
        if constexpr (!Epi::AFTER_DRAIN) { E(acc, cur, wr, wc, fr, fq); S.done(cur); }
        if (!has_next) break;
#pragma unroll
        for (int a = 0; a < 2; ++a)
#pragma unroll
            for (int b = 0; b < 2; ++b)
#pragma unroll
                for (int m = 0; m < 4; ++m)
#pragma unroll
                    for (int n = 0; n < 2; ++n) acc[a][b][m][n] = (f32x4){0.f, 0.f, 0.f, 0.f};
        cur = nxt; cA = nA; cB = nB; ++ui;
        if constexpr (ALIGN_EPI) { if (wr == 1) PG8_BAR; }
    }
    PG8_WAIT_V(0);
    if constexpr (!ALIGN_EPI) { if (wr == 0) PG8_BAR; }
    PG8_BAR;
#undef PG8_SA
#undef PG8_SB
#undef PG8_STAGE
#undef PG8_LDA
#undef PG8_LDB
#undef PG8_MMA
#undef PG8_WAIT_V
#undef PG8_WAIT_L
#undef PG8_BAR
#undef PG8_SCHED
}
}

typedef unsigned short bf16;
typedef float f32x4 __attribute__((ext_vector_type(4)));
typedef float f32x2 __attribute__((ext_vector_type(2)));
typedef float f32x16 __attribute__((ext_vector_type(16)));
typedef short bf16x8 __attribute__((ext_vector_type(8)));
typedef unsigned u32x4 __attribute__((ext_vector_type(4)));
typedef unsigned u32x2 __attribute__((ext_vector_type(2)));
typedef __bf16 bf16v2 __attribute__((ext_vector_type(2)));

constexpr int NW = 8, NT = 512;
constexpr int MTOK = 16384, SEQ = 2048, DM = 2048, NIN = 5408, NINP = 5632, NMODC = 12288;
constexpr size_t MiB = 1u << 20;
constexpr size_t WS_MOD = 1 * MiB, WS_KEYS = 2 * MiB, WS_W2T = WS_KEYS + 512 * 1024, WS_A2T = WS_W2T + 128 * 1024, WS_G2T = WS_A2T + 128 * 1024;
constexpr size_t WS_WIN = 4 * MiB, WS_WOUT = 26 * MiB, WS_WQ = 34 * MiB, WS_PU = 42 * MiB, WS_PV = 106 * MiB, WS_HB = 170 * MiB, WS_P = 234 * MiB;
constexpr size_t WS_KP = 410 * MiB, WS_KK = 442 * MiB, WS_BB = 474 * MiB, WS_VV = 506 * MiB, WS_END = 538 * MiB;
constexpr size_t WS_Y = WS_P, WS_Q = WS_P + 64 * MiB, WS_EIDX = WS_P + 128 * MiB, WS_GATE = WS_P + 136 * MiB;
constexpr size_t OUT_DEC = 0, OUT_G = 64 * MiB, OUT_R = 96 * MiB;
constexpr int LDS_BYTES = 147456;
constexpr int XB_LDS_OFF = 147456 - 64;
constexpr size_t CTL_ZERO_BYTES = 16384;
constexpr int NPHASE = 11;

struct Args { const float* in[29]; float* out; unsigned char* ws; int ph_lo, ph_hi; };

__device__ __forceinline__ float bf_lo(unsigned u) { return __uint_as_float(u << 16); }
__device__ __forceinline__ float bf_hi(unsigned u) { return __uint_as_float(u & 0xffff0000u); }
__device__ __forceinline__ float bf1(bf16 h) { return __uint_as_float((unsigned)h << 16); }
__device__ __forceinline__ unsigned pk2(float lo, float hi) { return pg8::cvt_pk_bf16(lo, hi); }
__device__ __forceinline__ bf16 f2bf(float f) { return (bf16)(pg8::cvt_pk_bf16(f, 0.f) & 0xffffu); }
template <int CTRL> __device__ __forceinline__ float dpp_mov(float v) { return __int_as_float(__builtin_amdgcn_update_dpp(0, __float_as_int(v), CTRL, 0xF, 0xF, true)); }
__device__ __forceinline__ float quad_sum(float v) { v += dpp_mov<0xB1>(v); v += dpp_mov<0x4E>(v); return v; }
__device__ __forceinline__ float row16_sum(float v) { v = quad_sum(v); v += dpp_mov<0x141>(v); v += dpp_mov<0x140>(v); return v; }
__device__ __forceinline__ float half32_sum(float v) { v = row16_sum(v); v += __shfl_xor(v, 16); return v; }
__device__ __forceinline__ float wave_sum(float v) { v = row16_sum(v); v += __shfl_xor(v, 16); v += __shfl_xor(v, 32); return v; }
__device__ __forceinline__ int kmax(int a, int b) { int r; asm("v_max_f32 %0, %1, %2" : "=v"(r) : "v"(a), "v"(b)); return r; }
__device__ __forceinline__ int kmin(int a, int b) { int r; asm("v_min_f32 %0, %1, %2" : "=v"(r) : "v"(a), "v"(b)); return r; }
__device__ __forceinline__ int kmed3(int a, int b, int c) { int r; asm("v_med3_f32 %0, %1, %2, %3" : "=v"(r) : "v"(a), "v"(b), "v"(c)); return r; }
__device__ __forceinline__ float gelu1(float x) { return 0.5f * x * (1.0f + erff(x * 0.70710678118654752f)); }
__device__ __forceinline__ float sigmoid1(float x) { return __builtin_amdgcn_rcpf(1.0f + __expf(-x)); }
__device__ __forceinline__ float tanh_fast(float x) { const float e = __expf(-2.0f * fabsf(x)); const float t = (1.0f - e) * __builtin_amdgcn_rcpf(1.0f + e); return x < 0.f ? -t : t; }

__device__ __forceinline__ void p0_transpose_item(const float* W, int K, int N, bf16* WT, float* scr, int item, int lane) {
    const int nblk = N / 32, kb = item / nblk, nb = item % nblk, k0 = 64 * kb, n0 = 32 * nb;
#pragma unroll 8
    for (int i = 0; i < 32; ++i) { const int kk = 2 * i + (lane >> 5); scr[kk * 33 + (lane & 31)] = W[(size_t)(k0 + kk) * N + n0 + (lane & 31)]; }
    asm volatile("s_waitcnt lgkmcnt(0)" ::: "memory");
    const int c = lane & 7;
#pragma unroll
    for (int j = 0; j < 4; ++j) { const int n = (lane >> 3) + 8 * j; const float* s = scr + (8 * c) * 33 + n;
        u32x4 o; o.x = pk2(s[0 * 33], s[1 * 33]); o.y = pk2(s[2 * 33], s[3 * 33]); o.z = pk2(s[4 * 33], s[5 * 33]); o.w = pk2(s[6 * 33], s[7 * 33]);
        *(u32x4*)(WT + (size_t)(n0 + n) * K + k0 + 8 * c) = o; }
    asm volatile("s_waitcnt lgkmcnt(0)" ::: "memory");
}

__device__ __forceinline__ void norm_mod_rows(const float* X, const float* g, const float* mod, int shi, int sci, bf16* H, int gw, int NGW, int lane, int rep = 1) {
    for (int t_ = gw; t_ < MTOK * rep; t_ += NGW) { const int t = t_ & (MTOK - 1);
        const int b = t >> 11;
        const f32x4* xr = (const f32x4*)(X + (size_t)t * DM) + lane;
        f32x4 v[8]; float ss = 0.f;
#pragma unroll
        for (int j = 0; j < 8; ++j) { v[j] = xr[64 * j]; ss += (v[j].x * v[j].x + v[j].y * v[j].y) + (v[j].z * v[j].z + v[j].w * v[j].w); }
        ss = wave_sum(ss);
        const float rinv = rsqrtf(ss * (1.0f / DM) + 1e-6f);
        const float* mb = mod + (size_t)b * NMODC;
#pragma unroll
        for (int j = 0; j < 8; ++j) { const int col = 4 * lane + 256 * j;
            const f32x4 g4 = *(const f32x4*)(g + col), sc4 = *(const f32x4*)(mb + sci * DM + col), sh4 = *(const f32x4*)(mb + shi * DM + col);
            const f32x4 o = (v[j] * rinv) * g4 * (sc4 + 1.0f) + sh4;
            u32x2 w; w.x = pk2(o.x, o.y); w.y = pk2(o.z, o.w);
            *(u32x2*)(H + (size_t)t * DM + col) = w; }
    }
}


#define LAS __attribute__((address_space(3)))
#define XB_TMO      128
#define XB_XCNT(j)  (256  + 64 * (j))
#define XB_XSUB(j)  (1280 + 64 * (j))
#define XB_XGEN(j)  (2304 + 64 * (j))
#define XB_TOP      3328
#define XB_TOPGEN   3392
#define XCD_BAR_WORDS 3456
#define XB_SPIN_CAP (1u << 18)

__device__ __forceinline__ unsigned xb_ld(unsigned* p)              { return __hip_atomic_load(p, __ATOMIC_RELAXED, __HIP_MEMORY_SCOPE_AGENT); }
__device__ __forceinline__ unsigned xb_add(unsigned* p, unsigned v) { return __hip_atomic_fetch_add(p, v, __ATOMIC_RELAXED, __HIP_MEMORY_SCOPE_AGENT); }
__device__ __forceinline__ unsigned xb_xcc_id() { return (unsigned)__builtin_amdgcn_s_getreg((3 << 11) | 20) & 0xFu; }
#define XB_SPIN(cond, bar) do { unsigned _sp = 0; while (cond) { __builtin_amdgcn_s_sleep(1); \
    if ((++_sp & 255u) == 0u) { if (xb_ld(&(bar)[XB_TMO])) break; if (_sp > XB_SPIN_CAP) { atomicAdd(&(bar)[XB_TMO], 1u); break; } } } } while (0)

struct XcdBarrier {
    unsigned* bar; unsigned x;
    volatile LAS unsigned* st;
};

__device__ __forceinline__ XcdBarrier xcd_barrier_post(unsigned* bar, volatile LAS unsigned* st) {
    XcdBarrier b; b.bar = bar; b.x = xb_xcc_id(); b.st = st;
    if (threadIdx.x == 0) (void)xb_add(&bar[XB_XCNT(b.x)], 1u);
    return b;
}
__device__ __forceinline__ void xcd_barrier_complete(unsigned* bar, unsigned x, unsigned& nloc, unsigned& nx) {
    const unsigned G = gridDim.x * gridDim.y * gridDim.z;
    unsigned sum, cnt, mine, sp = 0u;
    for (;;) {
        sum = 0u; cnt = 0u; mine = 0u;
#pragma unroll
        for (unsigned j = 0; j < 16; ++j) { const unsigned c = xb_ld(&bar[XB_XCNT(j)]); sum += c; cnt += (c > 0u) ? 1u : 0u; mine = (j == x) ? c : mine; }
        if (sum == G) break;
        __builtin_amdgcn_s_sleep(1);
        if ((++sp & 255u) == 0u) { if (xb_ld(&bar[XB_TMO])) break; if (sp > XB_SPIN_CAP) { atomicAdd(&bar[XB_TMO], 1u); break; } }
    }
    nloc = mine > 0u ? mine : 1u; nx = cnt > 0u ? cnt : 1u;
}

__device__ __forceinline__ void xcd_barrier(const XcdBarrier& b) {
    asm volatile("s_waitcnt vmcnt(0)" ::: "memory");
    __syncthreads();
    if (threadIdx.x == 0) {
        unsigned* bar = b.bar;
        __builtin_amdgcn_s_waitcnt(0);
        unsigned nloc = b.st[0], nx = b.st[1];
        if (nloc == 0u) { xcd_barrier_complete(bar, b.x, nloc, nx); b.st[0] = nloc; b.st[1] = nx; }
        const unsigned old = xb_add(&bar[XB_XSUB(b.x)], 1u);
        const unsigned gen = old / nloc;
        if (old + 1u == (gen + 1u) * nloc) {
            __builtin_amdgcn_fence(__ATOMIC_RELEASE, "agent");
            asm volatile("s_waitcnt vmcnt(0)" ::: "memory");
            const unsigned og = xb_add(&bar[XB_TOP], 1u);
            const unsigned tg = og / nx;
            if (og + 1u == (tg + 1u) * nx) xb_add(&bar[XB_TOPGEN], 1u);
            else XB_SPIN(xb_ld(&bar[XB_TOPGEN]) == tg, bar);
            __builtin_amdgcn_fence(__ATOMIC_ACQUIRE, "agent");
            xb_add(&bar[XB_XGEN(b.x)], 1u);
            asm volatile("s_waitcnt vmcnt(0)" ::: "memory");
        } else {
            XB_SPIN(xb_ld(&bar[XB_XGEN(b.x)]) == gen, bar);
            __builtin_amdgcn_fence(__ATOMIC_ACQUIRE, "agent");
            asm volatile("s_waitcnt vmcnt(0)" ::: "memory");
        }
    }
    __syncthreads();
}


#define CONVERT_EXPERT_ROWS(R0, R1, WID, NWV) do { \
    for (int r = (R0) + (WID); r < (R1); r += (NWV)) { \
        const int row = r & 16383; \
        const float* srcp = args.in[26] + (size_t)row * DM; \
        f32x4 v[8]; float am = 0.f; \
        _Pragma("unroll") for (int j = 0; j < 2; ++j) _Pragma("unroll") for (int q = 0; q < 4; ++q) { const f32x4 t = *(const f32x4*)(srcp + j * 1024 + lane * 16 + q * 4); v[j * 4 + q] = t; \
            am = fmaxf(am, fmaxf(fmaxf(fabsf(t.x), fabsf(t.y)), fmaxf(fabsf(t.z), fabsf(t.w)))); } \
        _Pragma("unroll") for (int o = 1; o < 64; o <<= 1) am = fmaxf(am, __shfl_xor(am, o)); \
        const float sc = am > 0.f ? 240.0f / am : 1.0f, inv = am > 0.f ? am * (1.0f / 240.0f) : 1.0f; \
        unsigned char* dst = PU8 + (size_t)row * DM; \
        _Pragma("unroll") for (int j = 0; j < 2; ++j) { u32x4 o; \
            _Pragma("unroll") for (int q = 0; q < 4; ++q) { const f32x4 t = v[j * 4 + q] * sc; int p = __builtin_amdgcn_cvt_pk_fp8_f32(t.x, t.y, 0, false); p = __builtin_amdgcn_cvt_pk_fp8_f32(t.z, t.w, p, true); o[q] = (unsigned)p; } \
            *(u32x4*)(dst + j * 1024 + lane * 16) = o; } \
        if (lane == 0) SCL[r] = inv; \
    } } while (0)
#define CONVERT_EXPERT_FP4_ROWS(SRC, DST, SCLP, WID, NWV) do { \
    for (int row = (WID); row < 16384; row += (NWV)) { \
        const float* srcp = (SRC) + (size_t)row * DM + lane * 32; \
        f32x4 v[8]; float am = 0.f, ss = 0.f; \
        _Pragma("unroll") for (int q = 0; q < 8; ++q) { const f32x4 t = *(const f32x4*)(srcp + q * 4); v[q] = t; \
            am = fmaxf(am, fmaxf(fmaxf(fabsf(t.x), fabsf(t.y)), fmaxf(fabsf(t.z), fabsf(t.w)))); ss += (t.x * t.x + t.y * t.y) + (t.z * t.z + t.w * t.w); } \
        _Pragma("unroll") for (int o = 1; o < 64; o <<= 1) am = fmaxf(am, __shfl_xor(am, o)); \
        ss = wave_sum(ss); \
        float unit = fmaxf(sqrtf(ss * (1.0f / DM)) * 0.5f, am * (1.0f / 9.0f)); if (!(unit > 0.f)) unit = 1.0f; \
        const float sc = 1.0f / unit; u32x4 o; \
        _Pragma("unroll") for (int d = 0; d < 4; ++d) { const f32x4 t0 = v[2 * d] * sc, t1 = v[2 * d + 1] * sc; unsigned p = 0u; \
            p = __builtin_amdgcn_cvt_scalef32_pk_fp4_f32(p, t0.x, t0.y, 1.0f, 0); p = __builtin_amdgcn_cvt_scalef32_pk_fp4_f32(p, t0.z, t0.w, 1.0f, 1); \
            p = __builtin_amdgcn_cvt_scalef32_pk_fp4_f32(p, t1.x, t1.y, 1.0f, 2); p = __builtin_amdgcn_cvt_scalef32_pk_fp4_f32(p, t1.z, t1.w, 1.0f, 3); o[d] = p; } \
        *(u32x4*)((DST) + (size_t)row * 1024 + lane * 16) = o; \
        if (lane == 0) (SCLP)[row] = unit; \
    } } while (0)

__global__ void __launch_bounds__(NT, 2) mk_fwd(Args args) {
    extern __shared__ __attribute__((aligned(16))) unsigned char lds[];
    const int tid = threadIdx.x, lane = tid & 63, wave = __builtin_amdgcn_readfirstlane(tid >> 6);
    const int G = gridDim.x, bx = blockIdx.x;
    const int gw = bx * NW + wave, NGW = G * NW;
    const int gtid = bx * NT + tid, NGT = G * NT;
    unsigned char* ws = args.ws;
    const int lo = args.ph_lo, hi = args.ph_hi;
    volatile LAS unsigned* xst = (volatile LAS unsigned*)((LAS unsigned char*)lds + XB_LDS_OFF);
    if (tid < 4) xst[tid] = 0u;
    __syncthreads();
    XcdBarrier xbar = xcd_barrier_post((unsigned*)ws, xst);
    if (args.ph_lo == -7777) cg::this_grid().sync();
#ifndef P3SEL
#define P3SEL(x) (x)
#endif
#ifndef PH_MASK
#define PH_MASK 0x7ff
#endif
#define IN(k) (((PH_MASK >> (k)) & 1) && lo <= (k) && (k) < hi)
#ifndef PROBE_REP
#define PROBE_REP -1
#endif
#define REPS(k)
#define RMUL(k) ((k) == PROBE_REP ? 2 : 1)
#define SEAM(k) do { if (IN(k) && IN((k) + 1)) xcd_barrier(xbar); } while (0)

    const float* x = args.in[0];
    float* MOD = (float*)(ws + WS_MOD);
    bf16* KEYSB = (bf16*)(ws + WS_KEYS); bf16* W2T = (bf16*)(ws + WS_W2T); bf16* A2T = (bf16*)(ws + WS_A2T); bf16* G2T = (bf16*)(ws + WS_G2T);
    bf16* WIN = (bf16*)(ws + WS_WIN); bf16* WOUT = (bf16*)(ws + WS_WOUT); bf16* WQ = (bf16*)(ws + WS_WQ);
    unsigned char* PU8 = ws + WS_PU; unsigned char* PV8 = ws + WS_PU + 32 * MiB; float* SCL = (float*)(ws + WS_PV); bf16* HB = (bf16*)(ws + WS_HB); bf16* P = (bf16*)(ws + WS_P);
    bf16* KP = (bf16*)(ws + WS_KP); bf16* KKn = (bf16*)(ws + WS_KK); bf16* BB = (bf16*)(ws + WS_BB); bf16* VV = (bf16*)(ws + WS_VV);
    float* Y = (float*)(ws + WS_Y); bf16* Q = (bf16*)(ws + WS_Q); int* EIDX = (int*)(ws + WS_EIDX); float* GATE = (float*)(ws + WS_GATE);
    float* DEC = (float*)((unsigned char*)args.out + OUT_DEC); bf16* GG = (bf16*)((unsigned char*)args.out + OUT_G); bf16* RR = (bf16*)((unsigned char*)args.out + OUT_R);

    if (IN(0)) REPS(0) {
        if (bx < 192) {
            const float* c = args.in[1]; const float* ada_w = args.in[2]; const float* ada_b = args.in[3];
            float* sct = (float*)lds;
            for (int i = tid; i < 8 * 2048; i += NT) { const int b = i >> 11, k = i & 2047; const float cv = c[i]; sct[k * 8 + b] = cv / (1.0f + __expf(-cv)); }
            __syncthreads();
            const int n0 = bx * 64, rg = lane >> 4, cl = lane & 15;
            f32x4 acc[8];
#pragma unroll
            for (int b = 0; b < 8; ++b) acc[b] = (f32x4){0.f, 0.f, 0.f, 0.f};
            const float* wp = ada_w + (size_t)(wave * 256 + rg) * NMODC + n0 + cl * 4;
#pragma unroll 4
            for (int i = 0; i < 64; ++i) {
                const f32x4 w = *(const f32x4*)(wp + (size_t)i * 4 * NMODC);
                const int k = wave * 256 + i * 4 + rg;
                const f32x4 s0 = *(const f32x4*)(sct + k * 8), s1 = *(const f32x4*)(sct + k * 8 + 4);
                acc[0] += w * s0.x; acc[1] += w * s0.y; acc[2] += w * s0.z; acc[3] += w * s0.w;
                acc[4] += w * s1.x; acc[5] += w * s1.y; acc[6] += w * s1.z; acc[7] += w * s1.w;
            }
            float* red = (float*)(lds + 65536);
#pragma unroll
            for (int b = 0; b < 8; ++b) {
#pragma unroll
                for (int q = 0; q < 4; ++q) { float v = acc[b][q]; v += __shfl_xor(v, 16); v += __shfl_xor(v, 32); acc[b][q] = v; }
                if (rg == 0) *(f32x4*)(red + (wave * 8 + b) * 64 + cl * 4) = acc[b];
            }
            __syncthreads();
            { const int b = tid >> 6, col = tid & 63; float s = ada_b[n0 + col];
#pragma unroll
              for (int w = 0; w < 8; ++w) s += red[(w * 8 + b) * 64 + col];
              MOD[(size_t)b * NMODC + n0 + col] = s; }
            __syncthreads();
        }
        {
            float* scr = (float*)(lds + wave * 16384);
            constexpr int I_IN = (DM / 64) * (NIN / 32), I_SQ = (DM / 64) * (DM / 32);
            for (int it = gw; it < I_IN + 2 * I_SQ; it += NGW) {
                int r = it;
                if (r < I_IN) { p0_transpose_item(args.in[5], DM, NIN, WIN, scr, r, lane); continue; } r -= I_IN;
                if (r < I_SQ) { p0_transpose_item(args.in[22], DM, DM, WOUT, scr, r, lane); continue; } r -= I_SQ;
                p0_transpose_item(args.in[24], DM, DM, WQ, scr, r, lane);
            }
        }
        {
            u32x4* z = (u32x4*)(WIN + (size_t)NIN * DM);
            for (int i = gtid; i < (NINP - NIN) * DM / 8; i += NGT) z[i] = (u32x4){0u, 0u, 0u, 0u};
            const float* w2 = args.in[13]; const float* a2 = args.in[15]; const float* g2 = args.in[16]; const float* keys = args.in[25];
            for (int i = gtid; i < 1024 * 64; i += NGT) { const int n = i >> 6, k = i & 63; W2T[i] = f2bf(w2[k * 1024 + n]); A2T[i] = f2bf(a2[k * 1024 + n]); }
            for (int i = gtid; i < 1024 * 160; i += NGT) { const int n = i / 160, k = i % 160; G2T[i] = f2bf(g2[k * 1024 + n]); }
            for (int i = gtid; i < 262144 / 2; i += NGT) { const f32x2 v = *(const f32x2*)(keys + 2 * i); ((unsigned*)KEYSB)[i] = pk2(v.x, v.y); }
        }
    }
    SEAM(0);

    if (IN(1)) norm_mod_rows(x, args.in[4], MOD, 0, 1, HB, gw, NGW, lane, RMUL(1));
    SEAM(1);

    if (IN(2)) {
        pg8::Gemm g{HB, WIN, MTOK, NINP, DM}; pg8::StaticOrder S; S.init(MTOK, NINP, G, bx, RMUL(2));
        pg8::EpiBf16G E{P, NINP, 8};
        pg8::gemm_phase<pg8::EpiBf16G, pg8::StaticOrder, true, true>((PG8_LAS unsigned char*)lds, g, S, E);
        if (G == 256) { if (bx >= 128) CONVERT_EXPERT_FP4_ROWS(args.in[26], PU8, SCL, (bx - 128) * NW + wave, 128 * NW); }
        else CONVERT_EXPERT_FP4_ROWS(args.in[26], PU8, SCL, gw, NGW);
    }
    SEAM(2);

    if (IN(3)) REPS(3) {
        for (int item_ = bx; item_ < 256 * RMUL(3); item_ += G) {
            const int item = item_ & 255;
            __syncthreads();
            {
                const int t0 = item * 64;
                bf16* Al = (bf16*)lds;
                bf16* Ks = (bf16*)(lds + 40960);
                const float* mu = args.in[11];
                {
                    const int tl = tid >> 3, cb = (tid & 7) * 36; const int t = t0 + tl; const bool first = (t & (SEQ - 1)) == 0;
                    const bf16* cur = P + (size_t)t * NINP + 2048 + 3072 + cb; const bf16* prv = cur - NINP;
#pragma unroll 6
                    for (int q = 0; q < 18; ++q) { const unsigned c2 = *(const unsigned*)(cur + 2 * q); const unsigned p2 = first ? 0u : *(const unsigned*)(prv + 2 * q);
                        const int c = cb + 2 * q; const float m0 = mu[3072 + c], m1 = mu[3072 + c + 1];
                        float v0 = bf_lo(c2), v1 = bf_hi(c2); v0 += (bf_lo(p2) - v0) * m0; v1 += (bf_hi(p2) - v1) * m1;
                        if (c < 64) { v0 = tanh_fast(v0); v1 = tanh_fast(v1); } else if (c >= 128) { v0 = sigmoid1(v0); v1 = sigmoid1(v1); }
                        *(unsigned*)(Al + tl * 296 + c) = pk2(v0, v1); }
                }
                const int c0 = wave * 128;
                const float* w0p = args.in[12]; const float* a0p = args.in[14]; const float* kkw = args.in[17]; const float* kaw = args.in[18];
#define RW_ZERO() do { _Pragma("unroll") for (int b_ = 0; b_ < 4; ++b_) _Pragma("unroll") for (int r_ = 0; r_ < 16; ++r_) acc[b_][r_] = 0.f; } while (0)
#define RW_MM(BT, KB, ACOL, NKS) do { _Pragma("unroll 2") for (int ks = 0; ks < (NKS); ++ks) { bf16x8 bfr[4]; \
        const bf16x8 af = *(const bf16x8*)(Al + (mt * 32 + (lane & 31)) * 296 + (ACOL) + ks * 16 + (lane >> 5) * 8); \
        _Pragma("unroll") for (int b_ = 0; b_ < 4; ++b_) bfr[b_] = *(const bf16x8*)((BT) + (size_t)(c0 + b_ * 32 + (lane & 31)) * (KB) + ks * 16 + (lane >> 5) * 8); \
        _Pragma("unroll") for (int b_ = 0; b_ < 4; ++b_) acc[b_] = __builtin_amdgcn_mfma_f32_32x32x16_bf16(af, bfr[b_], acc[b_], 0, 0, 0); } } while (0)
#pragma unroll 1
                for (int mt = 0; mt < 2; ++mt) {
                    __syncthreads();
#pragma unroll 6
                    for (int op = tid; op < 3 * 32 * 128; op += NT) {
                        const int which = op >> 12, tl = (op >> 7) & 31, c8 = (op & 127) * 8; const int t = t0 + mt * 32 + tl; const bool first = (t & (SEQ - 1)) == 0;
                        const bf16* cp = P + (size_t)t * NINP + 2048 + which * 1024 + c8;
                        const u32x4 cu = *(const u32x4*)cp; u32x4 pr = (u32x4){0u, 0u, 0u, 0u}; if (!first) pr = *(const u32x4*)(cp - NINP);
                        const f32x4 m0 = *(const f32x4*)(mu + which * 1024 + c8), m1 = *(const f32x4*)(mu + which * 1024 + c8 + 4);
                        u32x4 o;
                        { float a = bf_lo(cu.x), b = bf_hi(cu.x); a += (bf_lo(pr.x) - a) * m0.x; b += (bf_hi(pr.x) - b) * m0.y; o.x = pk2(a, b); }
                        { float a = bf_lo(cu.y), b = bf_hi(cu.y); a += (bf_lo(pr.y) - a) * m0.z; b += (bf_hi(pr.y) - b) * m0.w; o.y = pk2(a, b); }
                        { float a = bf_lo(cu.z), b = bf_hi(cu.z); a += (bf_lo(pr.z) - a) * m1.x; b += (bf_hi(pr.z) - b) * m1.y; o.z = pk2(a, b); }
                        { float a = bf_lo(cu.w), b = bf_hi(cu.w); a += (bf_lo(pr.w) - a) * m1.z; b += (bf_hi(pr.w) - b) * m1.w; o.w = pk2(a, b); }
                        if (which == 0) *(u32x4*)(RR + (size_t)t * 1024 + c8) = o;
                        else if (which == 2) *(u32x4*)(VV + (size_t)t * 1024 + c8) = o;
                        else *(u32x4*)(Ks + tl * 1032 + c8) = o;
                    }
                    __syncthreads();
                    f32x16 acc[4];
                    RW_ZERO(); RW_MM(W2T, 64, 0, 4);
#pragma unroll
                    for (int nt = 0; nt < 4; ++nt) { const int col = c0 + nt * 32 + (lane & 31); const float w0v = w0p[col];
#pragma unroll
                        for (int r = 0; r < 16; ++r) { const int t = t0 + mt * 32 + (r & 3) + 8 * (r >> 2) + 4 * (lane >> 5);
                            const float sg = sigmoid1(w0v + acc[nt][r]);
                            DEC[(size_t)t * 1024 + col] = __expf(-0.60653065971f * sg); }
                        asm volatile("" ::: "memory"); }
                    RW_ZERO(); RW_MM(A2T, 64, 64, 4);
#pragma unroll
                    for (int hh = 0; hh < 2; ++hh) {
                        const int colA = c0 + hh * 64 + (lane & 31), colB = colA + 32;
                        const float a0A = a0p[colA], a0B = a0p[colB], kkA = kkw[colA], kkB = kkw[colB], kaA = kaw[colA], kaB = kaw[colB];
#pragma unroll
                        for (int r = 0; r < 16; ++r) { const int tl = (r & 3) + 8 * (r >> 2) + 4 * (lane >> 5); const int t = t0 + mt * 32 + tl;
                            const float kA = bf1(Ks[tl * 1032 + colA]), kB = bf1(Ks[tl * 1032 + colB]);
                            const float aA = sigmoid1(a0A + acc[hh * 2][r]), aB = sigmoid1(a0B + acc[hh * 2 + 1][r]);
                            const float qA = kA * kkA, qB = kB * kkB;
                            const float ss = half32_sum(qA * qA + qB * qB);
                            const float inv = __builtin_amdgcn_rsqf(fmaxf(ss, 1e-24f));
                            const float nA = qA * inv, nB = qB * inv;
                            const size_t oA = (size_t)t * 1024 + colA, oB = oA + 32;
                            KP[oA] = f2bf(kA * (1.0f + (aA - 1.0f) * kaA)); KP[oB] = f2bf(kB * (1.0f + (aB - 1.0f) * kaB));
                            KKn[oA] = f2bf(nA); KKn[oB] = f2bf(nB); BB[oA] = f2bf(nA * aA); BB[oB] = f2bf(nB * aB);
                            if ((r & 3) == 3) asm volatile("" ::: "memory"); }
                    }
                    RW_ZERO(); RW_MM(G2T, 160, 128, 10);
#pragma unroll
                    for (int nt = 0; nt < 4; ++nt) { const int col = c0 + nt * 32 + (lane & 31);
#pragma unroll
                        for (int r = 0; r < 16; ++r) { const int t = t0 + mt * 32 + (r & 3) + 8 * (r >> 2) + 4 * (lane >> 5);
                            GG[(size_t)t * 1024 + col] = f2bf(acc[nt][r]); }
                        asm volatile("" ::: "memory"); }
                }
            }
        }
#undef RW_ZERO
#undef RW_MM
        for (int item_ = bx; item_ < 256 * RMUL(3); item_ += G) {
            const int item = item_ & 255;
            __syncthreads();
            {
                const int T0 = (item >> 1) * 128, hg = (item & 1) * 4;
                bf16* VnT = (bf16*)lds;
                f32x2* st = (f32x2*)(lds + 36864);
                const float* vg = args.in[6]; const float* vb = args.in[7]; const float* wsp = args.in[8]; const float* bs = args.in[9];
#pragma unroll 1
                for (int i0 = 0; i0 < 16; i0 += 4) {
                    u32x4 a[4], b[4];
#pragma unroll
                    for (int i = 0; i < 4; ++i) { const bf16* row = P + (size_t)(T0 + wave * 16 + i0 + i) * NINP + 1024; a[i] = *(const u32x4*)(row + lane * 8); b[i] = *(const u32x4*)(row + 512 + lane * 8); }
#pragma unroll
                    for (int i = 0; i < 4; ++i) { float s = 0.f, s2 = 0.f;
#pragma unroll
                        for (int q = 0; q < 4; ++q) { const float v0 = bf_lo(a[i][q]), v1 = bf_hi(a[i][q]), v2 = bf_lo(b[i][q]), v3 = bf_hi(b[i][q]); s += (v0 + v1) + (v2 + v3); s2 += (v0 * v0 + v1 * v1) + (v2 * v2 + v3 * v3); }
                        s = wave_sum(s); s2 = wave_sum(s2);
                        const float mean = s * (1.0f / 1024.0f); const float var = fmaxf(s2 * (1.0f / 1024.0f) - mean * mean, 0.f);
                        if (lane == 0) st[wave * 16 + i0 + i] = (f32x2){mean, rsqrtf(var + 1e-5f)}; }
                }
                for (int hh = 0; hh < 4; ++hh) {
                    const int h = hg + hh;
                    __syncthreads();
                    {
                        const int j = tid >> 2, d0 = (tid & 3) * 32; const f32x2 sj = st[j];
                        const bf16* src = P + (size_t)(T0 + j) * NINP + 1024 + h * 128 + d0;
                        u32x4 a[4];
#pragma unroll
                        for (int q = 0; q < 4; ++q) a[q] = *(const u32x4*)(src + q * 8);
#pragma unroll
                        for (int q = 0; q < 4; ++q) {
#pragma unroll
                            for (int e = 0; e < 4; ++e) { const int d = d0 + q * 8 + e * 2; const int col = h * 128 + d;
                                const float v0 = (bf_lo(a[q][e]) - sj.x) * sj.y * vg[col] + vb[col], v1 = (bf_hi(a[q][e]) - sj.x) * sj.y * vg[col + 1] + vb[col + 1];
                                VnT[d * 136 + j] = f2bf(v0); VnT[(d + 1) * 136 + j] = f2bf(v1); } }
                    }
                    __syncthreads();
                    const int it_ = wave >> 1, dt0 = (wave & 1) * 2, nks = (it_ < 2) ? 4 : 8;
                    bf16 gu[2][16];
#pragma unroll
                    for (int q = 0; q < 2; ++q)
#pragma unroll
                        for (int r = 0; r < 16; ++r) { const int i = it_ * 32 + (r & 3) + 8 * (r >> 2) + 4 * (lane >> 5), d = (dt0 + q) * 32 + (lane & 31);
                            gu[q][r] = P[(size_t)(T0 + i) * NINP + h * 128 + d]; }
                    f32x16 acc[2];
#pragma unroll
                    for (int q = 0; q < 2; ++q)
#pragma unroll
                        for (int r = 0; r < 16; ++r) acc[q][r] = 0.f;
                    const float* wrow = wsp + ((size_t)h * 128 + it_ * 32 + (lane & 31)) * 128 + (lane >> 5) * 8;
#pragma unroll 2
                    for (int ks = 0; ks < nks; ++ks) {
                        const f32x4 w0 = *(const f32x4*)(wrow + ks * 16), w1 = *(const f32x4*)(wrow + ks * 16 + 4);
                        u32x4 au; au.x = pk2(w0.x, w0.y); au.y = pk2(w0.z, w0.w); au.z = pk2(w1.x, w1.y); au.w = pk2(w1.z, w1.w);
                        const bf16x8 af = __builtin_bit_cast(bf16x8, au);
#pragma unroll
                        for (int q = 0; q < 2; ++q) { const bf16x8 bfr = *(const bf16x8*)(VnT + ((dt0 + q) * 32 + (lane & 31)) * 136 + ks * 16 + (lane >> 5) * 8);
                            acc[q] = __builtin_amdgcn_mfma_f32_32x32x16_bf16(af, bfr, acc[q], 0, 0, 0); }
                    }
#pragma unroll
                    for (int q = 0; q < 2; ++q)
#pragma unroll
                        for (int r = 0; r < 16; ++r) { const int i = it_ * 32 + (r & 3) + 8 * (r >> 2) + 4 * (lane >> 5), d = (dt0 + q) * 32 + (lane & 31);
                            const float z = acc[q][r] + bs[h * 128 + i];
                            HB[(size_t)(T0 + i) * DM + h * 128 + d] = f2bf(bf1(gu[q][r]) * z); }
                }
            }
        }
    }
    SEAM(3);

    if (IN(4)) {
        constexpr int TC = 32, BUF = 45056;
        float* yp = (float*)(lds + BUF);
#define LDS_BARRIER() do { asm volatile("s_waitcnt lgkmcnt(0)" ::: "memory"); __builtin_amdgcn_s_barrier(); asm volatile("" ::: "memory"); } while (0)
        for (int task_ = bx; task_ < 256 * RMUL(4); task_ += G) {
            const int task = task_ & 255; const int bh = task >> 1, half = task & 1, b = bh >> 4, h = bh & 15;
            const int stp = tid >> 4, q = tid & 15;
            const size_t base = ((size_t)b * SEQ + stp) * 1024 + h * 64;
            f32x4 ld_dec; u32x2 ld_kk, ld_bb, ld_kp, ld_rr; unsigned ld_vv;
#define SC_LOAD(tc) do { const size_t o_ = base + (size_t)(tc) * 1024 + q * 4; ld_dec = *(const f32x4*)(DEC + o_); ld_kk = *(const u32x2*)(KKn + o_); ld_bb = *(const u32x2*)(BB + o_); \
            ld_kp = *(const u32x2*)(KP + o_); ld_rr = *(const u32x2*)(RR + o_); ld_vv = *(const unsigned*)(VV + base + (size_t)(tc) * 1024 + half * 32 + q * 2); } while (0)
#define SC_STORE() do { float* B_ = (float*)lds; const int o_ = stp * 64 + q * 4; *(f32x4*)(B_ + o_) = ld_dec; \
            *(f32x4*)(B_ + 2048 + o_) = (f32x4){-bf_lo(ld_kk.x), -bf_hi(ld_kk.x), -bf_lo(ld_kk.y), -bf_hi(ld_kk.y)}; \
            *(f32x4*)(B_ + 4096 + o_) = (f32x4){bf_lo(ld_bb.x), bf_hi(ld_bb.x), bf_lo(ld_bb.y), bf_hi(ld_bb.y)}; \
            *(f32x4*)(B_ + 6144 + o_) = (f32x4){bf_lo(ld_kp.x), bf_hi(ld_kp.x), bf_lo(ld_kp.y), bf_hi(ld_kp.y)}; \
            *(f32x4*)(B_ + 8192 + o_) = (f32x4){bf_lo(ld_rr.x), bf_hi(ld_rr.x), bf_lo(ld_rr.y), bf_hi(ld_rr.y)}; \
            *(f32x2*)(B_ + 10240 + stp * 32 + q * 2) = (f32x2){bf_lo(ld_vv), bf_hi(ld_vv)}; } while (0)
            __syncthreads();
            SC_LOAD(0); SC_STORE();
            __syncthreads();
            f32x4 S = (f32x4){0.f, 0.f, 0.f, 0.f};
            const int row = wave * 4 + (lane >> 4), kl = lane & 15;
            const float* B_ = (const float*)lds;
            for (int c = 0; c < SEQ / TC; ++c) {
                if (c + 1 < SEQ / TC) SC_LOAD((c + 1) * TC);
#define SC_LD(W, A, Bv, K, R, V, s_) do { const float* p_ = B_ + (s_) * 64 + kl * 4; W = *(const f32x4*)p_; A = *(const f32x4*)(p_ + 2048); Bv = *(const f32x4*)(p_ + 4096); K = *(const f32x4*)(p_ + 6144); R = *(const f32x4*)(p_ + 8192); V = B_[10240 + (s_) * 32 + row]; } while (0)
#define SC_STEP(W, A, Bv, K, R, V, s_) do { float sa_ = S.x * A.x; sa_ = fmaf(S.y, A.y, sa_); sa_ = fmaf(S.z, A.z, sa_); sa_ = fmaf(S.w, A.w, sa_); \
                    sa_ = row16_sum(sa_); S = S * W + Bv * sa_ + K * V; \
                    float y_ = S.x * R.x; y_ = fmaf(S.y, R.y, y_); y_ = fmaf(S.z, R.z, y_); y_ = fmaf(S.w, R.w, y_); yp[((s_) * 32 + row) * 20 + kl] = y_; } while (0)
                f32x4 w0, a0, b0, k0, r0, w1, a1, b1, k1, r1; float v0, v1;
                SC_LD(w0, a0, b0, k0, r0, v0, 0);
#pragma unroll
                for (int s = 0; s < TC; s += 2) {
                    SC_LD(w1, a1, b1, k1, r1, v1, s + 1);
                    SC_STEP(w0, a0, b0, k0, r0, v0, s);
                    if (s + 2 < TC) SC_LD(w0, a0, b0, k0, r0, v0, s + 2);
                    SC_STEP(w1, a1, b1, k1, r1, v1, s + 1);
                }
#undef SC_LD
#undef SC_STEP
                LDS_BARRIER();
#pragma unroll
                for (int o2 = 0; o2 < 2; ++o2) {
                    const int oi = tid + o2 * NT; const float* pp = yp + oi * 20; const f32x4 p0 = *(const f32x4*)pp, p1 = *(const f32x4*)(pp + 4), p2 = *(const f32x4*)(pp + 8), p3 = *(const f32x4*)(pp + 12);
                    const f32x4 t = (p0 + p1) + (p2 + p3);
                    Y[((size_t)b * SEQ + c * TC + (oi >> 5)) * 1024 + h * 64 + half * 32 + (oi & 31)] = (t.x + t.y) + (t.z + t.w); }
                if (c + 1 < SEQ / TC) SC_STORE();
                LDS_BARRIER();
            }
#undef SC_LOAD
#undef SC_STORE
        }
#undef LDS_BARRIER
    }
    SEAM(4);

    if (IN(5)) {
        const float* rk = args.in[19]; const float* lng = args.in[20]; const float* lnb = args.in[21]; const float* og = args.in[10];
        for (int t_ = gw; t_ < MTOK * RMUL(5); t_ += NGW) { const int t = t_ & (MTOK - 1);
            const size_t o = (size_t)t * 1024 + lane * 16;
            f32x4 y[4];
#pragma unroll
            for (int j = 0; j < 4; ++j) y[j] = *(const f32x4*)(Y + o + 4 * j);
            float s = 0.f;
#pragma unroll
            for (int j = 0; j < 4; ++j) s += (y[j].x + y[j].y) + (y[j].z + y[j].w);
            s = quad_sum(s); const float mean = s * (1.0f / 64.0f);
            float s2 = 0.f;
#pragma unroll
            for (int j = 0; j < 4; ++j) { y[j] = y[j] - mean; s2 += (y[j].x * y[j].x + y[j].y * y[j].y) + (y[j].z * y[j].z + y[j].w * y[j].w); }
            s2 = quad_sum(s2); const float rstd = rsqrtf(s2 * (1.0f / 64.0f) + 64e-5f);
            u32x4 r8[2], k8[2], v8[2], g8[2];
#pragma unroll
            for (int j = 0; j < 2; ++j) { r8[j] = *(const u32x4*)(RR + o + 8 * j); k8[j] = *(const u32x4*)(KP + o + 8 * j); v8[j] = *(const u32x4*)(VV + o + 8 * j); g8[j] = *(const u32x4*)(GG + o + 8 * j); }
            float dp = 0.f;
#pragma unroll
            for (int j = 0; j < 2; ++j)
#pragma unroll
                for (int e = 0; e < 4; ++e) { const int col = lane * 16 + j * 8 + e * 2; dp += bf_lo(r8[j][e]) * bf_lo(k8[j][e]) * rk[col] + bf_hi(r8[j][e]) * bf_hi(k8[j][e]) * rk[col + 1]; }
            dp = quad_sum(dp);
            u32x4 ov[2];
#pragma unroll
            for (int j = 0; j < 2; ++j)
#pragma unroll
                for (int e = 0; e < 4; ++e) { const int c = j * 8 + e * 2; const int col = lane * 16 + c;
                    const float y0 = y[c >> 2][c & 3], y1 = y[(c + 1) >> 2][(c + 1) & 3];
                    const float o0 = (y0 * rstd * lng[col] + lnb[col] + dp * bf_lo(v8[j][e])) * bf_lo(g8[j][e]);
                    const float o1 = (y1 * rstd * lng[col + 1] + lnb[col + 1] + dp * bf_hi(v8[j][e])) * bf_hi(g8[j][e]);
                    ov[j][e] = pk2(o0, o1); }
            bf16* op = HB + (size_t)t * DM + 1024 + lane * 16;
            *(u32x4*)op = ov[0]; *(u32x4*)(op + 8) = ov[1];
            {
                bf16* ap = HB + (size_t)t * DM + lane * 16; u32x4 ya[2]; ya[0] = *(const u32x4*)ap; ya[1] = *(const u32x4*)(ap + 8);
                float q2 = 0.f;
#pragma unroll
                for (int j = 0; j < 2; ++j)
#pragma unroll
                    for (int e = 0; e < 4; ++e) { const float v0 = bf_lo(ya[j][e]), v1 = bf_hi(ya[j][e]); q2 += v0 * v0 + v1 * v1; }
                q2 = wave_sum(q2);
                const float ri = rsqrtf(q2 * (1.0f / 1024.0f) + 1e-6f);
#pragma unroll
                for (int j = 0; j < 2; ++j)
#pragma unroll
                    for (int e = 0; e < 4; ++e) { const int col = lane * 16 + j * 8 + e * 2; ya[j][e] = pk2(bf_lo(ya[j][e]) * ri * og[col], bf_hi(ya[j][e]) * ri * og[col + 1]); }
                *(u32x4*)ap = ya[0]; *(u32x4*)(ap + 8) = ya[1];
            }
        }
    }
    SEAM(5);

    if (IN(6)) {
        pg8::Gemm g{HB, WOUT, MTOK, DM, DM}; pg8::StaticOrder S; S.init(MTOK, DM, G, bx, RMUL(6));
        pg8::EpiRes E{x, args.out, MOD + 2 * DM, NMODC};
        pg8::gemm_phase<pg8::EpiRes, pg8::StaticOrder, true, true>((PG8_LAS unsigned char*)lds, g, S, E);
    }
    SEAM(6);

    if (IN(7)) norm_mod_rows(args.out, args.in[23], MOD, 3, 4, HB, gw, NGW, lane);
    SEAM(7);

    if (IN(8)) {
        pg8::Gemm g{HB, WQ, MTOK, DM, DM}; pg8::StaticOrder S; S.init(MTOK, DM, G, bx);
        pg8::EpiBf16G E{Q, DM, 0};
        pg8::gemm_phase<pg8::EpiBf16G, pg8::StaticOrder, true, true>((PG8_LAS unsigned char*)lds, g, S, E);
    }
    SEAM(8);

    if (IN(9)) REPS(9) {
        float* scr = (float*)(lds + wave * 8704);
        for (int task_ = gw; task_ < (MTOK / 64) * 8 * RMUL(9); task_ += NGW) {
            const int task = task_ & 2047; const int tt = task >> 3, h = task & 7;
            int T0[16], T1[16];
#pragma unroll
            for (int p = 0; p < 2; ++p) {
                int T[16];
#pragma unroll
                for (int j = 0; j < 16; ++j) T[j] = (int)0xff7fffff;
                const bf16* qa = Q + (size_t)(tt * 64 + (lane & 31)) * DM + h * 256 + p * 128 + (lane >> 5) * 8;
                for (int nc = 0; nc < 4; ++nc) {
                    f32x16 acc[2];
#pragma unroll
                    for (int mt = 0; mt < 2; ++mt)
#pragma unroll
                        for (int r = 0; r < 16; ++r) acc[mt][r] = 0.f;
                    const bf16* kb = KEYSB + ((size_t)(h * 2 + p) * 128 + nc * 32 + (lane & 31)) * 128 + (lane >> 5) * 8;
#pragma unroll
                    for (int ks = 0; ks < 8; ++ks) { const bf16x8 bfr = *(const bf16x8*)(kb + ks * 16);
                        const bf16x8 af0 = *(const bf16x8*)(qa + ks * 16), af1 = *(const bf16x8*)(qa + (size_t)32 * DM + ks * 16);
                        acc[0] = __builtin_amdgcn_mfma_f32_32x32x16_bf16(af0, bfr, acc[0], 0, 0, 0);
                        acc[1] = __builtin_amdgcn_mfma_f32_32x32x16_bf16(af1, bfr, acc[1], 0, 0, 0); }
#pragma unroll
                    for (int mt = 0; mt < 2; ++mt)
#pragma unroll
                        for (int r = 0; r < 16; ++r) scr[(mt * 32 + (r & 3) + 8 * (r >> 2) + 4 * (lane >> 5)) * 33 + (lane & 31)] = acc[mt][r];
                    asm volatile("s_waitcnt lgkmcnt(0)" ::: "memory");
#pragma unroll 4
                    for (int j = 0; j < 32; ++j) {
                        int key = (__float_as_int(scr[lane * 33 + j]) & ~127) | (127 - (nc * 32 + j));
#pragma unroll
                        for (int u = 0; u < 16; u += 2) {
                            const int t0_ = T[u], t1_ = T[u + 1]; T[u] = kmax(t0_, key); T[u + 1] = kmed3(t0_, t1_, key); key = kmin(t1_, key); }
                    }
                    asm volatile("s_waitcnt lgkmcnt(0)" ::: "memory");
                }
#pragma unroll
                for (int j = 0; j < 16; ++j) { if (p == 0) T0[j] = T[j]; else T1[j] = T[j]; }
            }
            float tv[16]; int te[16];
#pragma unroll
            for (int j = 0; j < 16; ++j) { tv[j] = -3.0e38f; te[j] = 0; }
#pragma unroll
            for (int i = 0; i < 16; ++i)
#pragma unroll
                for (int j = 0; j < 16; ++j) if ((i + 1) * (j + 1) <= 16) {
                    const int m0 = T0[i] & ~127, m1 = T1[j] & ~127;
                    const float s0 = __int_as_float(m0), s1 = __int_as_float(m1);
                    float fv = s0 + s1; int pe = ((127 - (T0[i] & 127)) << 7) | (127 - (T1[j] & 127));
#pragma unroll
                    for (int u = 0; u < 16; ++u) { const bool c = fv > tv[u]; const float nv = c ? fv : tv[u]; const int ne = c ? pe : te[u]; fv = c ? tv[u] : fv; pe = c ? te[u] : pe; tv[u] = nv; te[u] = ne; }
                }
            {
                const float mx = tv[0]; float sum = 0.f;
#pragma unroll
                for (int j = 0; j < 16; ++j) { tv[j] = __expf(tv[j] - mx); sum += tv[j]; }
                const float inv = 1.0f / sum;
#pragma unroll
                for (int j = 0; j < 16; ++j) tv[j] *= inv;
            }
            const size_t o = (size_t)(tt * 64 + lane) * 128 + h * 16;
#pragma unroll
            for (int j = 0; j < 16; ++j) { EIDX[o + j] = te[j]; GATE[o + j] = tv[j]; }
        }
        CONVERT_EXPERT_FP4_ROWS(args.in[27], PV8, SCL + 16384, gw, NGW);
    }
    SEAM(9);

    if (IN(10)) {
        const float* fg = args.in[28];
        for (int tok = gw; tok < MTOK; tok += NGW) {
            const int b = tok >> 11;
            f32x2 hf2[16];
#pragma unroll
            for (int j = 0; j < 4; ++j) { const u32x4 a = *(const u32x4*)(HB + (size_t)tok * DM + lane * 32 + j * 8);
#pragma unroll
                for (int q = 0; q < 4; ++q) hf2[j * 4 + q] = (f32x2){bf_lo(a[q]), bf_hi(a[q])}; }
            const int e0 = EIDX[(size_t)tok * 128 + lane], e1 = EIDX[(size_t)tok * 128 + 64 + lane];
            const float g0 = GATE[(size_t)tok * 128 + lane], g1 = GATE[(size_t)tok * 128 + 64 + lane];
            const bool hi32 = (lane & 32) != 0, hi16 = (lane & 16) != 0; const int l3 = (lane & 3) << 4;
#define PU_LOAD(BUF, EV, S0) do { _Pragma("unroll") for (int i = 0; i < 8; ++i) { const int row_ = __builtin_amdgcn_readlane(EV, (S0) + i); BUF[i & 3][i >> 2] = *(const u32x4*)(PU8 + (size_t)row_ * 1024 + lane * 16); } } while (0)
#define PU_DOT4(BUF, H, S0) do { float d_[4]; _Pragma("unroll") for (int i = 0; i < 4; ++i) { f32x2 da_ = (f32x2){0.f, 0.f}; \
        _Pragma("unroll") for (int q = 0; q < 4; ++q) { const unsigned w_ = BUF[i][H][q]; \
            da_ = __builtin_elementwise_fma(__builtin_amdgcn_cvt_scalef32_pk_f32_fp4(w_, 1.0f, 0), hf2[q * 4 + 0], da_); da_ = __builtin_elementwise_fma(__builtin_amdgcn_cvt_scalef32_pk_f32_fp4(w_, 1.0f, 1), hf2[q * 4 + 1], da_); \
            da_ = __builtin_elementwise_fma(__builtin_amdgcn_cvt_scalef32_pk_f32_fp4(w_, 1.0f, 2), hf2[q * 4 + 2], da_); da_ = __builtin_elementwise_fma(__builtin_amdgcn_cvt_scalef32_pk_f32_fp4(w_, 1.0f, 3), hf2[q * 4 + 3], da_); } d_[i] = da_.x + da_.y; } \
        float k0_ = hi32 ? d_[2] : d_[0], k1_ = hi32 ? d_[3] : d_[1]; const float s0_ = hi32 ? d_[0] : d_[2], s1_ = hi32 ? d_[1] : d_[3]; \
        k0_ += __shfl_xor(s0_, 32); k1_ += __shfl_xor(s1_, 32); float k_ = hi16 ? k1_ : k0_; const float s_ = hi16 ? k0_ : k1_; k_ += __shfl_xor(s_, 16); k_ = row16_sum(k_); \
        const float t_ = __shfl(k_, l3); if ((lane >> 2) == ((S0) >> 2)) dv = t_; } while (0)
            float act0 = 0.f, act1 = 0.f;
            u32x4 bA[4][2], bB[4][2];
#pragma unroll
            for (int hh = 0; hh < 2; ++hh) {
                const int ev = hh ? e1 : e0; const float gv = hh ? g1 : g0; float dv = 0.f;
                PU_LOAD(bA, ev, 0);
#pragma unroll 1
                for (int s = 0; s < 64; s += 16) {
                    PU_LOAD(bB, ev, s + 8);
                    PU_DOT4(bA, 0, s); PU_DOT4(bA, 1, s + 4);
                    if (s + 16 < 64) PU_LOAD(bA, ev, s + 16);
                    PU_DOT4(bB, 0, s + 8); PU_DOT4(bB, 1, s + 12);
                }
                const float d = dv * SCL[ev];
                const float a = gelu1(d) * gv * SCL[16384 + ev];
                if (hh) act1 = a; else act0 = a;
            }
#undef PU_LOAD
#undef PU_DOT4
            f32x2 acc2[16];
#pragma unroll
            for (int i = 0; i < 16; ++i) acc2[i] = (f32x2){0.f, 0.f};
#define PV_LOAD(BUF, EV, S0) do { _Pragma("unroll") for (int i = 0; i < 8; ++i) { const int row_ = __builtin_amdgcn_readlane(EV, (S0) + i); BUF[i & 3][i >> 2] = *(const u32x4*)(PV8 + (size_t)row_ * 1024 + lane * 16); } } while (0)
#define PV_ACC(BUF, AV, S0) do { _Pragma("unroll") for (int i = 0; i < 8; ++i) { const float a_ = __int_as_float(__builtin_amdgcn_readlane(__float_as_int(AV), (S0) + i)); const f32x2 a2_ = (f32x2){a_, a_}; \
        _Pragma("unroll") for (int q = 0; q < 4; ++q) { const unsigned w_ = BUF[i & 3][i >> 2][q]; \
            acc2[q * 4 + 0] = __builtin_elementwise_fma(a2_, __builtin_amdgcn_cvt_scalef32_pk_f32_fp4(w_, 1.0f, 0), acc2[q * 4 + 0]); acc2[q * 4 + 1] = __builtin_elementwise_fma(a2_, __builtin_amdgcn_cvt_scalef32_pk_f32_fp4(w_, 1.0f, 1), acc2[q * 4 + 1]); \
            acc2[q * 4 + 2] = __builtin_elementwise_fma(a2_, __builtin_amdgcn_cvt_scalef32_pk_f32_fp4(w_, 1.0f, 2), acc2[q * 4 + 2]); acc2[q * 4 + 3] = __builtin_elementwise_fma(a2_, __builtin_amdgcn_cvt_scalef32_pk_f32_fp4(w_, 1.0f, 3), acc2[q * 4 + 3]); } } } while (0)
#pragma unroll
            for (int hh = 0; hh < 2; ++hh) {
                const int ev = hh ? e1 : e0; const float av = hh ? act1 : act0;
                PV_LOAD(bA, ev, 0);
#pragma unroll 1
                for (int s = 0; s < 64; s += 16) {
                    PV_LOAD(bB, ev, s + 8);
                    PV_ACC(bA, av, s);
                    if (s + 16 < 64) PV_LOAD(bA, ev, s + 16);
                    PV_ACC(bB, av, s + 8);
                }
            }
#undef PV_LOAD
#undef PV_ACC
            float acc[32];
#pragma unroll
            for (int i = 0; i < 16; ++i) { acc[2 * i] = acc2[i].x; acc[2 * i + 1] = acc2[i].y; }
            float* xr = args.out + (size_t)tok * DM + lane * 32; const float* gt2 = MOD + (size_t)b * NMODC + 5 * DM + lane * 32;
            float ss = 0.f;
#pragma unroll
            for (int q = 0; q < 8; ++q) { const f32x4 xv = *(const f32x4*)(xr + q * 4), g4 = *(const f32x4*)(gt2 + q * 4);
                float* a = acc + q * 4;
                a[0] = xv.x + g4.x * a[0]; a[1] = xv.y + g4.y * a[1]; a[2] = xv.z + g4.z * a[2]; a[3] = xv.w + g4.w * a[3];
                ss += (a[0] * a[0] + a[1] * a[1]) + (a[2] * a[2] + a[3] * a[3]); }
            ss = wave_sum(ss);
            const float rinv = rsqrtf(ss * (1.0f / DM) + 1e-6f);
#pragma unroll
            for (int q = 0; q < 8; ++q) { const f32x4 f4 = *(const f32x4*)(fg + lane * 32 + q * 4); const float* a = acc + q * 4;
                *(f32x4*)(xr + q * 4) = (f32x4){a[0] * rinv * f4.x, a[1] * rinv * f4.y, a[2] * rinv * f4.z, a[3] * rinv * f4.w}; }
        }
    }
#undef IN
#undef SEAM
}

extern "C" void kernel_launch(void* const* d_in, const int* in_sizes, int n_in, void* d_out, int out_size, void* d_ws, size_t ws_size, hipStream_t stream) {
    static int grid = 0;
    if (grid == 0) {
        if (n_in != 29 || ws_size < WS_END) { fprintf(stderr, "kernel_launch: unexpected n_in %d / ws %zu\n", n_in, ws_size); grid = -1; return; }
        int dev = 0, cus = 0, per_cu = 0;
        hipGetDevice(&dev); hipDeviceGetAttribute(&cus, hipDeviceAttributeMultiprocessorCount, dev);
        hipFuncSetAttribute((const void*)mk_fwd, hipFuncAttributeMaxDynamicSharedMemorySize, LDS_BYTES);
        hipOccupancyMaxActiveBlocksPerMultiprocessor(&per_cu, (const void*)mk_fwd, NT, LDS_BYTES);
        if (per_cu < 1) { fprintf(stderr, "kernel_launch: occupancy query says %d\n", per_cu); per_cu = 1; }
        if (per_cu > 1) per_cu = 1;
        grid = cus * per_cu;
        (void)hipGetLastError();
    }
    if (grid < 0) return;
    Args a{};
    for (int i = 0; i < 29; ++i) a.in[i] = (const float*)d_in[i];
    a.out = (float*)d_out; a.ws = (unsigned char*)d_ws;
#if MK_ONE_LAUNCH
    (void)hipMemsetAsync(d_ws, 0, CTL_ZERO_BYTES, stream);
    a.ph_lo = 0; a.ph_hi = NPHASE;
    void* kargs[] = {&a};
    hipError_t e = hipLaunchCooperativeKernel((const void*)mk_fwd, dim3(grid), dim3(NT), kargs, LDS_BYTES, stream);
    if (e != hipSuccess) fprintf(stderr, "cooperative launch failed: %s (grid %d)\n", hipGetErrorString(e), grid);
#else
    for (int p = 0; p < NPHASE; ++p) { a.ph_lo = p; a.ph_hi = p + 1; hipLaunchKernelGGL(mk_fwd, dim3(grid), dim3(NT), LDS_BYTES, stream, a); }
#endif
}
```
